# Optimizing an MI355X kernel written in HIP

```python
import jax, jax.numpy as jnp
from jax import lax
import numpy as np

D_MODEL = 2048
BATCH = 4
SEQ = 8192
DEPTH = 2

HEAD_DIM = 128
N_HEADS = D_MODEL // HEAD_DIM
N_HEADS_DIL = N_HEADS // 2
N_HEADS_NA = N_HEADS - N_HEADS_DIL
ROT_DIM = HEAD_DIM // 4
ROPE_THETA = 500000.0
DIL_PATTERNS = ((128, 1), (512, 4), (2048, 16))
BAND_BLOCK = 64
GRID_W = 64
NA_ROWS_MAX = 8
NA_COLS = 16
NA_Q_COLS = 16
NA_K_COLS = 32
D_FF = 4 * D_MODEL
EPS = 1e-6
NEG_INF = -1e30
W_DIL = 3 * N_HEADS_DIL * HEAD_DIM
W_NA = 3 * N_HEADS_NA * HEAD_DIM

kernel_name = 'hybrid_dilated_neighborhood_encoder'


def rms_norm_f32(x, g):
    xf = x.astype(jnp.float32)
    y = xf * lax.rsqrt(jnp.mean(xf * xf, axis=-1, keepdims=True) + EPS)
    return y * g.astype(jnp.float32)


def partial_rope(x):
    S = x.shape[1]
    pos = jnp.arange(S, dtype=jnp.float32)
    inv_freq = ROPE_THETA ** (-jnp.arange(0, ROT_DIM, 2, dtype=jnp.float32) / ROT_DIM)
    ang = pos[:, None] * inv_freq[None, :]
    cos = jnp.cos(ang)[None, :, None, :]
    sin = jnp.sin(ang)[None, :, None, :]
    half = ROT_DIM // 2
    x1 = x[..., :half]
    x2 = x[..., half:ROT_DIM]
    return jnp.concatenate([x1 * cos - x2 * sin, x2 * cos + x1 * sin, x[..., ROT_DIM:]], axis=-1)


def dilated_window_attn(q, k, v, window, dilation):
    B, S, H, hd = q.shape
    half = window // (2 * dilation)
    L = S // dilation
    nb = -(-L // BAND_BLOCK)
    Lp = nb * BAND_BLOCK
    pad = Lp - L

    def to_res(t):
        return t.reshape(B, L, dilation, H, hd).transpose(0, 2, 3, 1, 4)

    qr = jnp.pad(to_res(q), ((0, 0), (0, 0), (0, 0), (0, pad), (0, 0)))
    qb = qr.reshape(B, dilation, H, nb, BAND_BLOCK, hd)

    def band(t):
        tp = jnp.pad(to_res(t), ((0, 0), (0, 0), (0, 0), (BAND_BLOCK, BAND_BLOCK + pad), (0, 0)))
        tp = tp.reshape(B, dilation, H, nb + 2, BAND_BLOCK, hd)
        return jnp.concatenate([tp[:, :, :, :-2], tp[:, :, :, 1:-1], tp[:, :, :, 2:]], axis=4)

    kn = band(k)
    vn = band(v)
    n_i = np.arange(nb)[:, None, None]
    q_i = np.arange(BAND_BLOCK)[None, :, None]
    k_i = np.arange(3 * BAND_BLOCK)[None, None, :]
    rel = k_i - BAND_BLOCK - q_i
    key_abs = (n_i - 1) * BAND_BLOCK + k_i
    valid = (np.abs(rel) <= half) & (key_abs >= 0) & (key_abs < L)

    s = jnp.einsum('bzhnqd,bzhnkd->bzhnqk', qb, kn)
    s = jnp.where(valid, s, NEG_INF)
    m = jnp.max(s, axis=-1)
    p = jnp.exp(s - m[..., None])
    l = jnp.sum(p, axis=-1)
    o = jnp.einsum('bzhnqk,bzhnkd->bzhnqd', p, vn) / l[..., None]

    o = o.reshape(B, dilation, H, Lp, hd)[:, :, :, :L].transpose(0, 3, 1, 2, 4).reshape(B, S, H, hd)
    m = m.reshape(B, dilation, H, Lp)[..., :L].transpose(0, 3, 1, 2).reshape(B, S, H)
    l = l.reshape(B, dilation, H, Lp)[..., :L].transpose(0, 3, 1, 2).reshape(B, S, H)
    return o, m, l


def dilated_mixer(q, k, v):
    outs = [dilated_window_attn(q, k, v, w, d) for (w, d) in DIL_PATTERNS]
    m_all = jnp.stack([o[1] for o in outs], axis=0)
    m_max = jnp.max(m_all, axis=0)
    wts = jnp.stack([o[2] for o in outs], axis=0) * jnp.exp(m_all - m_max[None])
    o_all = jnp.stack([o[0] for o in outs], axis=0)
    return jnp.sum(wts[..., None] * o_all, axis=0) / jnp.sum(wts, axis=0)[..., None]


def neighborhood_attn(q, k, v, rpb):
    B, S, H, hd = q.shape
    rows = S // GRID_W
    kr = min(NA_ROWS_MAX, rows)
    ncb = GRID_W // NA_Q_COLS

    kstart = np.clip(np.arange(ncb) * NA_Q_COLS - NA_COLS // 2, 0, GRID_W - NA_K_COLS)
    colidx = kstart[:, None] + np.arange(NA_K_COLS)[None, :]
    qcol = (np.arange(ncb)[:, None] * NA_Q_COLS + np.arange(NA_Q_COLS)[None, :])[:, :, None]
    keycol = colidx[:, None, :]
    cs = np.clip(qcol - NA_COLS // 2, 0, GRID_W - NA_COLS)
    colmask = (keycol >= cs) & (keycol < cs + NA_COLS)
    coff = np.clip(keycol - qcol + NA_COLS - 1, 0, 2 * NA_COLS - 2)
    rpb_c = rpb.astype(jnp.float32)[:, :, coff]

    kg = k.reshape(B, rows, GRID_W, H, hd).transpose(0, 3, 1, 2, 4)
    vg = v.reshape(B, rows, GRID_W, H, hd).transpose(0, 3, 1, 2, 4)
    qg = q.reshape(B, rows, GRID_W, H, hd).transpose(1, 0, 3, 2, 4)

    def row_step(args):
        i, q_row = args
        rs = jnp.clip(i - kr // 2, 0, rows - kr)
        k_blk = lax.dynamic_slice_in_dim(kg, rs, kr, axis=2)[:, :, :, colidx]
        v_blk = lax.dynamic_slice_in_dim(vg, rs, kr, axis=2)[:, :, :, colidx]
        qb = q_row.reshape(B, H, ncb, NA_Q_COLS, hd)
        s = jnp.einsum('bhcqd,bhrckd->bhcqrk', qb, k_blk)
        roff = rs + jnp.arange(kr) - i + NA_ROWS_MAX - 1
        bias = rpb_c[:, roff].transpose(0, 2, 3, 1, 4)
        s = jnp.where(colmask[:, :, None, :], s + bias[None], NEG_INF)
        p = jax.nn.softmax(s.reshape(B, H, ncb, NA_Q_COLS, kr * NA_K_COLS), axis=-1)
        p = p.reshape(B, H, ncb, NA_Q_COLS, kr, NA_K_COLS)
        o = jnp.einsum('bhcqrk,bhrckd->bhcqd', p, v_blk)
        return o.reshape(B, H, GRID_W, hd)

    out = lax.map(row_step, (jnp.arange(rows), qg))
    return out.transpose(1, 0, 3, 2, 4).reshape(B, S, H, hd)


def setup_inputs(seed: int = 0) -> dict:
    key = jax.random.key(seed)
    ks = jax.random.split(key, 16)
    f32 = jnp.float32
    d = D_MODEL
    nrel_r = 2 * NA_ROWS_MAX - 1
    nrel_c = 2 * NA_COLS - 1
    return {
        'x': jax.random.normal(ks[0], (BATCH, SEQ, d), f32),
        'c': jax.random.normal(ks[1], (BATCH, d), f32),
        'ln1': 1.0 + 0.05 * jax.random.normal(ks[2], (DEPTH, d), f32),
        'w_ada': 0.5 * d ** -0.5 * jax.random.normal(ks[3], (DEPTH, d, 6 * d), f32),
        'b_ada': 0.01 * jax.random.normal(ks[4], (DEPTH, 6 * d), f32),
        'w_in': d ** -0.5 * jax.random.normal(ks[5], (DEPTH, d, W_DIL + W_NA), f32),
        'q_norm_dil': 1.0 + 0.05 * jax.random.normal(ks[6], (DEPTH, HEAD_DIM), f32),
        'k_norm_dil': 1.0 + 0.05 * jax.random.normal(ks[7], (DEPTH, HEAD_DIM), f32),
        'q_norm_na': 1.0 + 0.05 * jax.random.normal(ks[8], (DEPTH, HEAD_DIM), f32),
        'k_norm_na': 1.0 + 0.05 * jax.random.normal(ks[9], (DEPTH, HEAD_DIM), f32),
        'na_rel_bias': 0.1 * jax.random.normal(ks[10], (DEPTH, N_HEADS_NA, nrel_r, nrel_c), f32),
        'w_out': d ** -0.5 * jax.random.normal(ks[11], (DEPTH, d, d), f32),
        'ln2': 1.0 + 0.05 * jax.random.normal(ks[12], (DEPTH, d), f32),
        'w_mlp_in': d ** -0.5 * jax.random.normal(ks[13], (DEPTH, d, D_FF), f32),
        'w_mlp_out': D_FF ** -0.5 * jax.random.normal(ks[14], (DEPTH, D_FF, d), f32),
    }


def reference(x, c, ln1, w_ada, b_ada, w_in, q_norm_dil, k_norm_dil, q_norm_na, k_norm_na,
              na_rel_bias, w_out, ln2, w_mlp_in, w_mlp_out):
    B, S, D = x.shape
    scale = HEAD_DIM ** -0.5
    c_act = jax.nn.silu(c)
    for layer in range(DEPTH):
        mod = (c_act @ w_ada[layer] + b_ada[layer]).astype(jnp.float32)
        sh1, sc1, g1, sh2, sc2, g2 = jnp.split(mod[:, None, :], 6, axis=-1)

        h = (rms_norm_f32(x, ln1[layer]) * (1.0 + sc1) + sh1).astype(x.dtype)
        proj = h @ w_in[layer]
        p_dil = proj[..., :W_DIL].astype(jnp.float32).reshape(B, S, 3, N_HEADS_DIL, HEAD_DIM)
        p_na = proj[..., W_DIL:].astype(jnp.float32).reshape(B, S, 3, N_HEADS_NA, HEAD_DIM)

        qa = partial_rope(rms_norm_f32(p_dil[:, :, 0], q_norm_dil[layer])) * scale
        ka = partial_rope(rms_norm_f32(p_dil[:, :, 1], k_norm_dil[layer]))
        out_a = dilated_mixer(qa, ka, p_dil[:, :, 2])

        qb = rms_norm_f32(p_na[:, :, 0], q_norm_na[layer]) * scale
        kb = rms_norm_f32(p_na[:, :, 1], k_norm_na[layer])
        out_b = neighborhood_attn(qb, kb, p_na[:, :, 2], na_rel_bias[layer])

        mixed = jnp.concatenate([out_a, out_b], axis=2).reshape(B, S, D).astype(x.dtype)
        x = (x + g1 * (mixed @ w_out[layer])).astype(x.dtype)

        h2 = (rms_norm_f32(x, ln2[layer]) * (1.0 + sc2) + sh2).astype(x.dtype)
        hid = jnp.square(jax.nn.relu(h2 @ w_mlp_in[layer]))
        x = (x + g2 * (hid @ w_mlp_out[layer])).astype(x.dtype)
    return x
```

```cpp
#include <hip/hip_runtime.h>
#include <hip/hip_cooperative_groups.h>
#include <cstdio>
#include <cstdint>
namespace cg = cooperative_groups;

#ifndef MK_MULTI
#define MK_MULTI 0
#endif

#define LAS __attribute__((address_space(3)))
typedef unsigned short bf16_t;
typedef short bf16x8 __attribute__((ext_vector_type(8)));
typedef short s16x4 __attribute__((ext_vector_type(4)));
typedef float f32x2 __attribute__((ext_vector_type(2)));
typedef float f32x4 __attribute__((ext_vector_type(4)));
typedef float f32x16 __attribute__((ext_vector_type(16)));
typedef unsigned u32x2 __attribute__((ext_vector_type(2)));
typedef unsigned u32x4 __attribute__((ext_vector_type(4)));
typedef __bf16 bf16x2_t __attribute__((ext_vector_type(2)));

constexpr int MTOK = 32768, DM = 2048, SEQ = 8192, NQKV = 6144, DFF = 8192;
constexpr int LDS_BYTES = 151552 + 16;
constexpr float QSCALE = 0.08838834764831845f * 1.4426950408889634f;
constexpr float EPSN = 1e-6f;

constexpr size_t OFF_WT_IN = 0;
constexpr size_t OFF_WT_OUT = OFF_WT_IN + (size_t)NQKV * DM * 2;
constexpr size_t OFF_WT_MI = OFF_WT_OUT + (size_t)DM * DM * 2;
constexpr size_t OFF_WT_MO = OFF_WT_MI + (size_t)DFF * DM * 2;
constexpr size_t OFF_MOD = OFF_WT_MO + (size_t)DM * DFF * 2;
constexpr size_t OFF_ROPE = OFF_MOD + (size_t)2 * 4 * 12288 * 4;
constexpr size_t OFF_H = OFF_ROPE + (size_t)SEQ * 32 * 4;
constexpr size_t OFF_BIG = OFF_H + (size_t)MTOK * DM * 2;
constexpr size_t OFF_PART = OFF_BIG + (size_t)MTOK * DFF * 2;
constexpr size_t OFF_ML = OFF_PART + (size_t)3 * MTOK * 1024 * 2;
constexpr size_t OFF_BAR = OFF_ML + (size_t)3 * MTOK * 8 * 8;
constexpr size_t WS_END = OFF_BAR + 16384;

struct Params {
    const float *x, *c, *ln1, *w_ada, *b_ada, *w_in, *qnd, *knd, *qnn, *knn, *rpb, *w_out, *ln2, *w_mi, *w_mo;
    float* out;
    unsigned char* ws;
};

__device__ __forceinline__ unsigned pk2(float lo, float hi) { f32x2 v = {lo, hi}; return __builtin_bit_cast(unsigned, __builtin_convertvector(v, bf16x2_t)); }
__device__ __forceinline__ float bf_lo(unsigned w) { return __uint_as_float(w << 16); }
__device__ __forceinline__ float bf_hi(unsigned w) { return __uint_as_float(w & 0xffff0000u); }
__device__ __forceinline__ int clampi(int v, int lo, int hi) { return v < lo ? lo : (v > hi ? hi : v); }

namespace pg8 {
constexpr int BM = 256, BK = 64, HALF = 128, HTB = HALF * BK * 2, STAGE_BYTES = 8 * HTB, NXCD = 8, WGM = 8;
__host__ __device__ __forceinline__ int lds_byte(int r, int c) { const int st = (r >> 4) * 2 + (c >> 5), rr = r & 15, cc = c & 31, ob = rr * 64 + cc * 2; return st * 1024 + (ob ^ (((ob >> 9) & 1) << 5)); }
__host__ __device__ __forceinline__ void stage_rc(int b, int& R, int& C) { const int st = b / 1024, sb = b % 1024, swz = sb ^ (((sb >> 9) & 1) << 5); R = (st >> 1) * 16 + swz / 64; C = (st & 1) * 32 + (swz % 64) / 2; }
__host__ __device__ __forceinline__ int perm32(int rho) { const int n = rho >> 4, i = rho & 15; return 8 * (i >> 2) + 4 * n + (i & 3); }

struct Unit { int pm, pn; };
struct Gemm { const bf16_t* A; const bf16_t* Bt; int M, N, K; };

struct StaticOrder {
    int nM, nN, nwg, G, c;
    __device__ void init(int M, int N, int G_, int c_) { nM = M / BM; nN = N / BM; nwg = nM * nN; G = G_; c = c_; }
    __device__ bool next(int i, Unit& u) const {
        const long L = (long)i * G + c; if (L >= nwg) return false;
        int wgid = (int)L; { const int q = nwg / NXCD, r = nwg % NXCD, xcd = wgid % NXCD, off = wgid / NXCD; wgid = (xcd < r ? xcd * (q + 1) : r * (q + 1) + (xcd - r) * q) + off; }
        const int nig = WGM * nN, gid = wgid / nig, fm = gid * WGM, gsz = (nM - fm) < WGM ? (nM - fm) : WGM;
        u.pm = fm + ((wgid % nig) % gsz); u.pn = (wgid % nig) / gsz; return true;
    }
};


template <bool RB, bool OB>
struct EpiResid {
    static constexpr bool PERM = true;
    void* out; const void* resid; const float* gate;
    __device__ __forceinline__ void operator()(const f32x4 (&acc)[2][2][4][2], const Unit& u, int wr, int wc, int fr, int fq) const {
        asm volatile("" : "+v"(fr), "+v"(fq));
        const int row0 = u.pm * BM + wr * 64 + fr, col0 = u.pn * BM + wc * 32 + 8 * fq;
        const float* gp = gate + (size_t)(u.pm >> 5) * 12288 + col0;
        f32x4 gv[2][2];
#pragma unroll
        for (int bj = 0; bj < 2; ++bj)
#pragma unroll
            for (int n = 0; n < 2; ++n) gv[bj][n] = *(const f32x4*)(gp + bj * HALF + 4 * n);
#pragma unroll
        for (int ai = 0; ai < 2; ++ai)
#pragma unroll
            for (int m = 0; m < 4; ++m) {
                const size_t ro = (size_t)(row0 + ai * HALF + m * 16) * DM + col0;
#pragma unroll
                for (int bj = 0; bj < 2; ++bj) {
                    f32x4 r0, r1;
                    if (RB) { const u32x4 rw = *(const u32x4*)((const bf16_t*)resid + ro + bj * HALF);
                        r0 = (f32x4){bf_lo(rw.x), bf_hi(rw.x), bf_lo(rw.y), bf_hi(rw.y)}; r1 = (f32x4){bf_lo(rw.z), bf_hi(rw.z), bf_lo(rw.w), bf_hi(rw.w)}; }
                    else { r0 = *(const f32x4*)((const float*)resid + ro + bj * HALF); r1 = *(const f32x4*)((const float*)resid + ro + bj * HALF + 4); }
                    const f32x4 v0 = r0 + gv[bj][0] * acc[ai][bj][m][0], v1 = r1 + gv[bj][1] * acc[ai][bj][m][1];
                    if (OB) { u32x4 w; w.x = pk2(v0[0], v0[1]); w.y = pk2(v0[2], v0[3]); w.z = pk2(v1[0], v1[1]); w.w = pk2(v1[2], v1[3]); *(u32x4*)((bf16_t*)out + ro + bj * HALF) = w; }
                    else { *(f32x4*)((float*)out + ro + bj * HALF) = v0; *(f32x4*)((float*)out + ro + bj * HALF + 4) = v1; }
                }
            }
    }
};

struct EpiRelu2 {
    static constexpr bool PERM = true;
    bf16_t* O; int ldc;
    __device__ __forceinline__ void operator()(const f32x4 (&acc)[2][2][4][2], const Unit& u, int wr, int wc, int fr, int fq) const {
        asm volatile("" : "+v"(fr), "+v"(fq));
        const int row0 = u.pm * BM + wr * 64 + fr, col0 = u.pn * BM + wc * 32 + 8 * fq;
#pragma unroll
        for (int ai = 0; ai < 2; ++ai)
#pragma unroll
            for (int m = 0; m < 4; ++m) {
                bf16_t* rowp = O + (size_t)(row0 + ai * HALF + m * 16) * ldc + col0;
#pragma unroll
                for (int bj = 0; bj < 2; ++bj) {
                    f32x4 v0 = acc[ai][bj][m][0], v1 = acc[ai][bj][m][1];
#pragma unroll
                    for (int j = 0; j < 4; ++j) { const float a = fmaxf(v0[j], 0.f), b = fmaxf(v1[j], 0.f); v0[j] = a * a; v1[j] = b * b; }
                    u32x4 w; w.x = pk2(v0[0], v0[1]); w.y = pk2(v0[2], v0[3]); w.z = pk2(v1[0], v1[1]); w.w = pk2(v1[2], v1[3]);
                    *(u32x4*)(rowp + bj * HALF) = w;
                }
            }
    }
};

struct EpiQKV {
    static constexpr bool PERM = true;
    bf16_t* O; const float *qnd, *knd, *qnn, *knn; const float* rope; LAS float* T;
    __device__ __forceinline__ void operator()(const f32x4 (&acc)[2][2][4][2], const Unit& u, int wr, int wc, int fr, int fq) const {
        asm volatile("" : "+v"(fr), "+v"(fq));
        const int type = (u.pn >> 2) % 3, grp = u.pn / 12;
        const int row0 = u.pm * BM + wr * 64 + fr, col0 = u.pn * BM + wc * 32 + 8 * fq;
        if (type == 2) {
#pragma unroll
            for (int ai = 0; ai < 2; ++ai)
#pragma unroll
                for (int m = 0; m < 4; ++m) {
                    bf16_t* rowp = O + ((size_t)(2 * u.pn) * MTOK + (row0 + ai * HALF + m * 16)) * 128 + wc * 32 + 8 * fq;
#pragma unroll
                    for (int bj = 0; bj < 2; ++bj) { const f32x4 v0 = acc[ai][bj][m][0], v1 = acc[ai][bj][m][1];
                        u32x4 w; w.x = pk2(v0[0], v0[1]); w.y = pk2(v0[2], v0[3]); w.z = pk2(v1[0], v1[1]); w.w = pk2(v1[2], v1[3]); *(u32x4*)(rowp + (size_t)bj * MTOK * 128) = w; }
                }
            return;
        }
#pragma unroll
        for (int ai = 0; ai < 2; ++ai)
#pragma unroll
            for (int m = 0; m < 4; ++m)
#pragma unroll
                for (int bj = 0; bj < 2; ++bj) {
                    const f32x4 a = acc[ai][bj][m][0], b = acc[ai][bj][m][1];
                    float s = (a[0] * a[0] + a[1] * a[1]) + (a[2] * a[2] + a[3] * a[3]) + (b[0] * b[0] + b[1] * b[1]) + (b[2] * b[2] + b[3] * b[3]);
                    s += __shfl_xor(s, 16); s += __shfl_xor(s, 32);
                    if (fq == 0) T[((wr * 128 + ai * 64 + m * 16 + fr) * 2 + bj) * 4 + wc] = s;
                }
        asm volatile("s_waitcnt lgkmcnt(0)" ::: "memory"); __builtin_amdgcn_s_barrier(); asm volatile("" ::: "memory");
        const float *ga = qnd, *gb = knd, *gc = qnn, *gd = knn;
        asm volatile("" : "+s"(ga), "+s"(gb), "+s"(gc), "+s"(gd));
        const float* g = type == 0 ? (grp == 0 ? ga : gc) : (grp == 0 ? gb : gd);
        f32x4 gm[2];
#pragma unroll
        for (int n = 0; n < 2; ++n) gm[n] = *(const f32x4*)(g + wc * 32 + 8 * fq + 4 * n);
        const float mul = type == 0 ? QSCALE : 1.0f;
        const bool dorope = (grp == 0) && (wc == 0);
        const float sgn = (fq < 2) ? -1.0f : 1.0f;
#pragma unroll
        for (int ai = 0; ai < 2; ++ai)
#pragma unroll
            for (int m = 0; m < 4; ++m) {
                const int row = row0 + ai * HALF + m * 16;
                f32x4 cs[2] = {{1.f, 1.f, 1.f, 1.f}, {1.f, 1.f, 1.f, 1.f}}, sn[2] = {{0.f, 0.f, 0.f, 0.f}, {0.f, 0.f, 0.f, 0.f}};
                if (dorope) { const float* rp = rope + (size_t)(row & (SEQ - 1)) * 32 + 8 * (fq & 1);
                    cs[0] = *(const f32x4*)rp; cs[1] = *(const f32x4*)(rp + 4); sn[0] = *(const f32x4*)(rp + 16); sn[1] = *(const f32x4*)(rp + 20);
                    sn[0] = sn[0] * sgn; sn[1] = sn[1] * sgn; }
                bf16_t* rowp = O + ((size_t)(2 * u.pn) * MTOK + row) * 128 + wc * 32 + 8 * fq;
#pragma unroll
                for (int bj = 0; bj < 2; ++bj) {
                    const f32x4 t4 = *(const LAS f32x4*)(T + ((wr * 128 + ai * 64 + m * 16 + fr) * 2 + bj) * 4);
                    const float rstd = rsqrtf(((t4[0] + t4[1]) + (t4[2] + t4[3])) * (1.0f / 128.0f) + EPSN);
                    f32x4 v0 = acc[ai][bj][m][0] * rstd * gm[0], v1 = acc[ai][bj][m][1] * rstd * gm[1];
                    if (dorope) {
                        f32x4 p0, p1;
#pragma unroll
                        for (int e = 0; e < 4; ++e) { p0[e] = __shfl_xor(v0[e], 32); p1[e] = __shfl_xor(v1[e], 32); }
                        v0 = v0 * cs[0] + p0 * sn[0]; v1 = v1 * cs[1] + p1 * sn[1];
                    }
                    v0 = v0 * mul; v1 = v1 * mul;
                    u32x4 w; w.x = pk2(v0[0], v0[1]); w.y = pk2(v0[2], v0[3]); w.z = pk2(v1[0], v1[1]); w.w = pk2(v1[2], v1[3]);
                    *(u32x4*)(rowp + (size_t)bj * MTOK * 128) = w;
                }
            }
    }
};

template <class Epi>
__device__ __forceinline__ void gemm_phase(LAS unsigned char* lds, const Gemm g, const StaticOrder& S, const Epi& E, const int tid) {
    const int wid = __builtin_amdgcn_readfirstlane(tid >> 6), lane = tid & 63, wr = wid >> 2, wc = wid & 3, fr = lane & 15, fq = lane >> 4;
    const int K = g.K, nt = K / BK;
    unsigned voffA[2], voffB[2];
#pragma unroll
    for (int i = 0; i < 2; ++i) { int R, C; stage_rc(tid * 16 + i * 8192, R, C); const int Rb = Epi::PERM ? ((R & ~31) + perm32(R & 31)) : R;
        voffA[i] = (unsigned)(R * K + C) * 2u; voffB[i] = (unsigned)(Rb * K + C) * 2u; }
    const size_t kstep = (size_t)(BK * 2);
    const size_t hstep = (size_t)HALF * K * 2;
    const size_t tstep = 2 * hstep;
    const unsigned ldsw = (unsigned)wid * 1024u;
    const int aoff = lds_byte(wr * 64 + fr, fq * 8), boff = lds_byte(wc * 32 + fr, fq * 8);
#define PG8_SA(b, h) (((b) * 2 + (h)) * HTB)
#define PG8_SB(b, h) ((4 + (b) * 2 + (h)) * HTB)
#define PG8_STAGE(bufoff, gbase, voff) do { _Pragma("unroll") for (int _i = 0; _i < 2; ++_i) \
        __builtin_amdgcn_global_load_lds((const unsigned*)((const char*)(gbase) + (voff)[_i]), (LAS unsigned*)(lds + (bufoff) + ldsw + _i * 8192), 16, 0, 0); } while (0)
#define PG8_LDA(dst, b, h) do { _Pragma("unroll") for (int m = 0; m < 4; ++m) _Pragma("unroll") for (int k = 0; k < 2; ++k) dst[m][k] = *(const LAS bf16x8*)(lds + PG8_SA(b, h) + aoff + m * 2048 + k * 1024); } while (0)
#define PG8_LDB(dst, b, h) do { _Pragma("unroll") for (int n = 0; n < 2; ++n) _Pragma("unroll") for (int k = 0; k < 2; ++k) dst[n][k] = *(const LAS bf16x8*)(lds + PG8_SB(b, h) + boff + n * 2048 + k * 1024); } while (0)
#define PG8_MMA(ai, bj, At, Bt) do { __builtin_amdgcn_s_setprio(1); _Pragma("unroll") for (int m = 0; m < 4; ++m) _Pragma("unroll") for (int n = 0; n < 2; ++n) _Pragma("unroll") for (int k = 0; k < 2; ++k) \
        acc[ai][bj][m][n] = __builtin_amdgcn_mfma_f32_16x16x32_bf16(Bt[n][k], At[m][k], acc[ai][bj][m][n], 0, 0, 0); __builtin_amdgcn_s_setprio(0); } while (0)
#define PG8_WAIT_V(n) asm volatile("s_waitcnt vmcnt(" #n ")" ::: "memory")
#define PG8_WAIT_L(n) asm volatile("s_waitcnt lgkmcnt(" #n ")" ::: "memory")
#define PG8_BAR __builtin_amdgcn_s_barrier()
#define PG8_SCHED __builtin_amdgcn_sched_barrier(0)
    Unit cur, nxt; int ui = 0;
    if (!S.next(0, cur)) return;
    f32x4 acc[2][2][4][2];
#pragma unroll
    for (int a = 0; a < 2; ++a)
#pragma unroll
        for (int b = 0; b < 2; ++b)
#pragma unroll
            for (int m = 0; m < 4; ++m)
#pragma unroll
                for (int n = 0; n < 2; ++n) acc[a][b][m][n] = (f32x4){0.f, 0.f, 0.f, 0.f};
    bf16x8 At[4][2], B0[2][2], B1[2][2];
    const char* cA = (const char*)g.A + (size_t)cur.pm * tstep; const char* cB = (const char*)g.Bt + (size_t)cur.pn * tstep;
    PG8_STAGE(PG8_SB(0, 0), cB, voffB); PG8_STAGE(PG8_SA(0, 0), cA, voffA); PG8_STAGE(PG8_SB(0, 1), cB + hstep, voffB); PG8_STAGE(PG8_SA(0, 1), cA + hstep, voffA);
    if (wr == 1) PG8_BAR;
    PG8_WAIT_V(4); PG8_BAR;
    PG8_STAGE(PG8_SB(1, 0), cB + kstep, voffB); PG8_STAGE(PG8_SA(1, 0), cA + kstep, voffA); PG8_STAGE(PG8_SB(1, 1), cB + hstep + kstep, voffB);
    PG8_WAIT_V(6); PG8_BAR;
    for (;;) {
        const bool has_next = S.next(ui + 1, nxt);
        const char* nA = has_next ? (const char*)g.A + (size_t)nxt.pm * tstep : cA; const char* nB = has_next ? (const char*)g.Bt + (size_t)nxt.pn * tstep : cB;
        for (int t = 0; t < nt; t += 2) {
            const bool last = (t == nt - 2);
            const char* a1 = cA + (size_t)(t + 1) * kstep;
            const char* a2 = last ? nA : cA + (size_t)(t + 2) * kstep; const char* b2 = last ? nB : cB + (size_t)(t + 2) * kstep;
            const char* a3 = a2 + kstep; const char* b3 = b2 + kstep;
            PG8_LDB(B0, 0, 0); PG8_SCHED; PG8_LDA(At, 0, 0); PG8_STAGE(PG8_SA(1, 1), a1 + hstep, voffA);
            PG8_WAIT_L(8); PG8_BAR; PG8_WAIT_L(0); PG8_MMA(0, 0, At, B0); PG8_BAR; PG8_SCHED;
            PG8_LDB(B1, 0, 1); PG8_STAGE(PG8_SB(0, 0), b2, voffB);
            PG8_BAR; PG8_WAIT_L(0); PG8_MMA(0, 1, At, B1); PG8_BAR;
            PG8_LDA(At, 0, 1); PG8_STAGE(PG8_SA(0, 0), a2, voffA);
            PG8_BAR; PG8_WAIT_L(0); PG8_MMA(1, 0, At, B0); PG8_BAR; PG8_SCHED;
            PG8_STAGE(PG8_SB(0, 1), b2 + hstep, voffB);
            PG8_WAIT_V(6); PG8_BAR; PG8_MMA(1, 1, At, B1); PG8_BAR;
            PG8_LDB(B0, 1, 0); PG8_SCHED; PG8_LDA(At, 1, 0); PG8_STAGE(PG8_SA(0, 1), a2 + hstep, voffA);
            PG8_WAIT_L(8); PG8_BAR; PG8_WAIT_L(0); PG8_MMA(0, 0, At, B0); PG8_BAR; PG8_SCHED;
            PG8_LDB(B1, 1, 1); PG8_STAGE(PG8_SB(1, 0), b3, voffB);
            PG8_BAR; PG8_WAIT_L(0); PG8_MMA(0, 1, At, B1); PG8_BAR;
            PG8_LDA(At, 1, 1); PG8_STAGE(PG8_SA(1, 0), a3, voffA);
            PG8_BAR; PG8_WAIT_L(0); PG8_MMA(1, 0, At, B0); PG8_BAR; PG8_SCHED;
            PG8_STAGE(PG8_SB(1, 1), b3 + hstep, voffB);
            PG8_WAIT_V(6); PG8_BAR; PG8_MMA(1, 1, At, B1); PG8_BAR;
        }
        E(acc, cur, wr, wc, fr, fq);
        if (!has_next) break;
#pragma unroll
        for (int a = 0; a < 2; ++a)
#pragma unroll
            for (int b = 0; b < 2; ++b)
#pragma unroll
                for (int m = 0; m < 4; ++m)
#pragma unroll
                    for (int n = 0; n < 2; ++n) acc[a][b][m][n] = (f32x4){0.f, 0.f, 0.f, 0.f};
        cur = nxt; cA = nA; cB = nB; ++ui;
    }
    PG8_WAIT_V(0);
    if (wr == 0) PG8_BAR;
    PG8_BAR;
#undef PG8_SA
#undef PG8_SB
#undef PG8_STAGE
#undef PG8_LDA
#undef PG8_LDB
#undef PG8_MMA
#undef PG8_WAIT_V
#undef PG8_WAIT_L
#undef PG8_BAR
#undef PG8_SCHED
}
}

#define LDS_WAIT() asm volatile("s_waitcnt lgkmcnt(0)" ::: "memory")

__device__ __forceinline__ float wave_sum(float v) {
#pragma unroll
    for (int o = 1; o < 64; o <<= 1) v += __shfl_xor(v, o);
    return v;
}

__device__ __forceinline__ void transpose_item(const float* W, int K, int N, bf16_t* WT, LAS float* scr, int item, int lane) {
    const int nblk = N / 32, kb = item / nblk, nb = item % nblk, k0 = 64 * kb, n0 = 32 * nb;
#pragma unroll 8
    for (int i = 0; i < 32; ++i) { const int kk = 2 * i + (lane >> 5); scr[kk * 33 + (lane & 31)] = W[(size_t)(k0 + kk) * N + n0 + (lane & 31)]; }
    LDS_WAIT();
    const int c = lane & 7;
#pragma unroll
    for (int j = 0; j < 4; ++j) { const int n = (lane >> 3) + 8 * j; const LAS float* s = scr + (8 * c) * 33 + n;
        u32x4 o; o.x = pk2(s[0 * 33], s[1 * 33]); o.y = pk2(s[2 * 33], s[3 * 33]); o.z = pk2(s[4 * 33], s[5 * 33]); o.w = pk2(s[6 * 33], s[7 * 33]);
        *(u32x4*)(WT + (size_t)(n0 + n) * K + k0 + 8 * c) = o; }
    LDS_WAIT();
}

__device__ __forceinline__ void convert_weights(const Params& p, int l, LAS unsigned char* lds, const int tid, const int bid) {
    const int lane = tid & 63, wave = tid >> 6;
    LAS float* scr = (LAS float*)(lds + wave * 8704);
    const int gw = bid * 8 + wave, NGW = gridDim.x * 8;
    constexpr int I_IN = (DM / 64) * (NQKV / 32), I_OUT = (DM / 64) * (DM / 32), I_MI = (DM / 64) * (DFF / 32), I_MO = (DFF / 64) * (DM / 32);
    constexpr int NITEMS = I_IN + I_OUT + I_MI + I_MO;
    bf16_t* wt_in = (bf16_t*)(p.ws + OFF_WT_IN); bf16_t* wt_out = (bf16_t*)(p.ws + OFF_WT_OUT);
    bf16_t* wt_mi = (bf16_t*)(p.ws + OFF_WT_MI); bf16_t* wt_mo = (bf16_t*)(p.ws + OFF_WT_MO);
    for (int it = gw; it < NITEMS; it += NGW) {
        int r = it;
        if (r < I_IN) { transpose_item(p.w_in + (size_t)l * DM * NQKV, DM, NQKV, wt_in, scr, r, lane); continue; } r -= I_IN;
        if (r < I_OUT) { transpose_item(p.w_out + (size_t)l * DM * DM, DM, DM, wt_out, scr, r, lane); continue; } r -= I_OUT;
        if (r < I_MI) { transpose_item(p.w_mi + (size_t)l * DM * DFF, DM, DFF, wt_mi, scr, r, lane); continue; } r -= I_MI;
        transpose_item(p.w_mo + (size_t)l * DFF * DM, DFF, DM, wt_mo, scr, r, lane);
    }
}

__constant__ float c_inv_freq[16] = {1.0f, 0.44036660267178046f, 0.19392274474868576f, 0.08539710028576561f, 0.03760603093086393f, 0.016560440080994446f,
    0.007292664737217109f, 0.003211445994752591f, 0.001414213562373095f, 0.000622772421914596f, 0.0002742481756762073f, 0.00012076973741146504f,
    5.318295896944988e-05f, 2.341999896140934e-05f, 1.031338537721246e-05f, 4.5416704806078695e-06f};

__device__ __forceinline__ void rope_table(const Params& p, const int tid, const int bid) {
    float* rope = (float*)(p.ws + OFF_ROPE);
    const int gt = bid * 512 + tid, NT = gridDim.x * 512;
    for (int e = gt; e < SEQ * 16; e += NT) {
        const int pos = e >> 4, i = e & 15;
        const float ang = (float)pos * c_inv_freq[i];
        const double rev = (double)ang * 0.15915494309189533576888;
        const double fr = rev - __builtin_rint(rev);
        const float f = (float)fr;
        rope[pos * 32 + i] = __builtin_amdgcn_cosf(f);
        rope[pos * 32 + 16 + i] = __builtin_amdgcn_sinf(f);
    }
}

__device__ __forceinline__ void phase_mod(const Params& p, LAS unsigned char* lds, const int tid, const int bid) {
    LAS float* cact = (LAS float*)lds;
    LAS float* red = (LAS float*)(lds + 32768);
    float* mod = (float*)(p.ws + OFF_MOD);
    for (int i = tid; i < 4 * DM; i += 512) { const float v = p.c[i]; cact[i] = v / (1.0f + __expf(-v)); }
    __syncthreads();
    const int c4 = tid % 24, ks = tid / 24;
    for (int job = bid; job < 256; job += gridDim.x) {
        const int l = job >> 7, n0 = (job & 127) * 96;
        const float* W = p.w_ada + (size_t)l * DM * 12288 + n0 + c4 * 4;
        f32x4 a0 = {0.f, 0.f, 0.f, 0.f}, a1 = a0, a2 = a0, a3 = a0;
        if (ks < 21) {
            for (int k = ks; k < DM; k += 21) {
                const f32x4 w = *(const f32x4*)(W + (size_t)k * 12288);
                a0 += w * cact[k]; a1 += w * cact[DM + k]; a2 += w * cact[2 * DM + k]; a3 += w * cact[3 * DM + k];
            }
            LAS float* rp = red + ks * 384 + c4 * 4;
            *(LAS f32x4*)(rp) = a0; *(LAS f32x4*)(rp + 96) = a1; *(LAS f32x4*)(rp + 192) = a2; *(LAS f32x4*)(rp + 288) = a3;
        }
        __syncthreads();
        if (tid < 384) {
            const int b = tid / 96, n = tid % 96; float s = 0.f;
            for (int q = 0; q < 21; ++q) s += red[q * 384 + tid];
            mod[(size_t)(l * 4 + b) * 12288 + n0 + n] = s + p.b_ada[l * 12288 + n0 + n];
        }
        __syncthreads();
    }
}

template <bool XB>
__device__ __forceinline__ void phase_norm(const void* xin, bf16_t* H, const float* ln, const float* modl, int sh_off, int sc_off, const int tid, const int bid) {
    const int lane = tid & 63, wave = tid >> 6;
    const int gw = bid * 8 + wave, NGW = gridDim.x * 8;
    const int rpw = 16;
    for (int chunk = gw; chunk < MTOK / rpw; chunk += NGW) {
        const int row0 = chunk * rpw, b = row0 >> 13;
        f32x4 A[8], Bv[8];
#pragma unroll
        for (int q = 0; q < 8; ++q) {
            const int col = 8 * lane + 512 * (q >> 1) + 4 * (q & 1);
            const f32x4 lv = *(const f32x4*)(ln + col);
            const f32x4 sc = *(const f32x4*)(modl + (size_t)b * 12288 + sc_off + col);
            Bv[q] = *(const f32x4*)(modl + (size_t)b * 12288 + sh_off + col);
            A[q] = lv * (sc + 1.0f);
        }
        for (int r = 0; r < rpw; ++r) {
            f32x4 v[8]; float ss = 0.f;
            if (XB) {
                const bf16_t* xr = (const bf16_t*)xin + (size_t)(row0 + r) * DM + 8 * lane;
#pragma unroll
                for (int j = 0; j < 4; ++j) { const u32x4 w = *(const u32x4*)(xr + 512 * j);
                    v[2 * j] = (f32x4){bf_lo(w.x), bf_hi(w.x), bf_lo(w.y), bf_hi(w.y)}; v[2 * j + 1] = (f32x4){bf_lo(w.z), bf_hi(w.z), bf_lo(w.w), bf_hi(w.w)}; }
            } else {
                const float* xr = (const float*)xin + (size_t)(row0 + r) * DM + 8 * lane;
#pragma unroll
                for (int j = 0; j < 4; ++j) { v[2 * j] = *(const f32x4*)(xr + 512 * j); v[2 * j + 1] = *(const f32x4*)(xr + 512 * j + 4); }
            }
#pragma unroll
            for (int q = 0; q < 8; ++q) ss += (v[q][0] * v[q][0] + v[q][1] * v[q][1]) + (v[q][2] * v[q][2] + v[q][3] * v[q][3]);
            const float rstd = rsqrtf(wave_sum(ss) * (1.0f / DM) + EPSN);
            bf16_t* orow = H + (size_t)(row0 + r) * DM + 8 * lane;
#pragma unroll
            for (int j = 0; j < 4; ++j) { const f32x4 y0 = v[2 * j] * rstd * A[2 * j] + Bv[2 * j], y1 = v[2 * j + 1] * rstd * A[2 * j + 1] + Bv[2 * j + 1];
                u32x4 w; w.x = pk2(y0[0], y0[1]); w.y = pk2(y0[2], y0[3]); w.z = pk2(y1[0], y1[1]); w.w = pk2(y1[2], y1[3]); *(u32x4*)(orow + 512 * j) = w; }
        }
    }
}

#define MFMA32(a, b, c) __builtin_amdgcn_mfma_f32_32x32x16_bf16((a), (b), (c), 0, 0, 0)
constexpr int VBLK = 1056;
constexpr int VTILE = 8 * VBLK;
constexpr int PAIR_LDS = 4 * VTILE + 2048;

template <int NA>
__device__ __forceinline__ void attn_prefetch0(const Params& p, int u, int sub, int lane, LAS unsigned char* dst) {
    const bf16_t* QKV = (const bf16_t*)(p.ws + OFF_BIG);
    int b, head, kstride, kbase; bool valid;
    if (!NA) {
        const int qb = u & 127, rest = u >> 7, pidx = rest % 3, bh = rest / 3; b = bh >> 3; head = bh & 7;
        const int dsh = 2 * pidx, nq = 128 >> dsh, z = qb >> (7 - dsh), l0 = (qb & (nq - 1)) << 6;
        kstride = 1 << dsh; kbase = ((l0 - 64) << dsh) + z; valid = (l0 - 64) >= 0;
    } else {
        const int cb = u & 3, rq = (u >> 2) & 31, bh = u >> 7; b = bh >> 3; head = bh & 7;
        kstride = 1; kbase = clampi(4 * rq - 4, 0, 120) * 64 + clampi(16 * cb - 8, 0, 32); valid = true;
    }
    if (!valid) return;
    const int hs0 = (NA ? 24 : 0) + head;
    const bf16_t* gp = QKV + ((size_t)(hs0 + (sub ? 16 : 8)) * MTOK + b * SEQ + 8 * (lane >> 4) * kstride + kbase) * 128 + (((lane & 15) ^ (sub ? 0 : ((lane >> 4) & 1))) * 8);
    const size_t kstep = (size_t)kstride * 128;
#pragma unroll
    for (int t = 0; t < 8; ++t) { __builtin_amdgcn_global_load_lds((const unsigned*)gp, (LAS unsigned*)(dst + t * VBLK), 16, 0, 0); gp += kstep; asm volatile("" : "+v"(gp)); }
}

template <int NA, int MG>
__device__ __forceinline__ void attn_pair_unit(const Params& p, int l, int u, LAS unsigned char* pl, int sub, int lane, int& g, const bool own0, const int nu) {
    constexpr int NS = NA ? 11 : 6;
    const bf16_t* QKV = (const bf16_t*)(p.ws + OFF_BIG);
    const int r = lane & 31, h = lane >> 5;
    int b, head, qrow;
    int dsh = 0, z = 0, l0 = 0, L = 0, pidx = 0, lq = 0;
    int R0 = 0, Rlast = 0, kstart = 0, iq = 0, cq = 0, rsq = 0, csq = 0, ua = 0, ub = 0;
    if (!NA) {
        const int qb = u & 127, rest = u >> 7; pidx = rest % 3; const int bh = rest / 3; b = bh >> 3; head = bh & 7;
        dsh = 2 * pidx; L = SEQ >> dsh; const int nq = 128 >> dsh; z = qb >> (7 - dsh); l0 = (qb & (nq - 1)) << 6; lq = l0 + 32 * sub;
        qrow = b * SEQ + (((lq + r) << dsh) + z);
    } else {
        const int cb = u & 3, rq = (u >> 2) & 31; const int bh = u >> 7; b = bh >> 3; head = bh & 7;
        const int i0 = 4 * rq, iA = i0 + 2 * sub;
        R0 = clampi(i0 - 4, 0, 120); Rlast = clampi(i0 - 1, 0, 120) + 7;
        ua = clampi(iA - 4, 0, 120); ub = clampi(iA - 3, 0, 120) + 7;
        kstart = clampi(16 * cb - 8, 0, 32);
        iq = iA + (r >> 4); cq = 16 * cb + (r & 15); rsq = clampi(iq - 4, 0, 120); csq = clampi(cq - 8, 0, 48);
        qrow = b * SEQ + iq * 64 + cq;
    }
    const int hs0 = (NA ? 24 : 0) + head;
    const int kstride = NA ? 1 : (1 << dsh);
    const bf16_t* dp = QKV + ((size_t)(hs0 + (sub ? 16 : 8)) * MTOK + b * SEQ + 8 * (lane >> 4) * kstride) * 128 + (((lane & 15) ^ (sub ? 0 : ((lane >> 4) & 1))) * 8);
    LAS unsigned char* dl = pl + (sub ? 2 * VTILE : 0);
    const size_t kstep = (size_t)kstride * 128;
#define ATT_KBASE(c) (NA ? ((R0 + (c)) * 64 + kstart) : (((l0 - 64 + 32 * (c)) << dsh) + z))
#define ATT_CVALID(c) (NA ? (R0 + (c) <= Rlast) : ((l0 - 64 + 32 * (c)) >= 0 && (l0 - 64 + 32 * (c)) < L))
#define ATT_DMA(c, slot) do { const bf16_t* gp_ = dp + (size_t)ATT_KBASE(c) * 128; LAS unsigned char* lb_ = dl + (slot) * VTILE; \
        _Pragma("unroll") for (int t = 0; t < 8; ++t) { __builtin_amdgcn_global_load_lds((const unsigned*)gp_, (LAS unsigned*)(lb_ + t * VBLK), 16, 0, 0); gp_ += kstep; asm volatile("" : "+v"(gp_)); } } while (0)
    LAS float* bl = (LAS float*)(pl + 4 * VTILE);
    if (NA) { const float* rb = p.rpb + ((size_t)l * 8 + head) * 465; for (int i = lane; i < 465; i += 64) bl[i] = rb[i] * 1.4426950408889634f; LDS_WAIT(); }
    if (own0 && ATT_CVALID(0)) ATT_DMA(0, g & 1);
    bf16x8 qf[8];
    { const bf16_t* qp = QKV + ((size_t)hs0 * MTOK + qrow) * 128 + 8 * h;
#pragma unroll
      for (int kk = 0; kk < 8; ++kk) qf[kk] = *(const bf16x8*)(qp + 16 * kk); }
    f32x16 o[4];
#pragma unroll
    for (int db = 0; db < 4; ++db)
#pragma unroll
        for (int i = 0; i < 16; ++i) o[db][i] = 0.f;
    float m_run = -1e30f, l_run = 0.f;
    const int i16 = lane & 15, tq = i16 >> 2, tp = i16 & 3, blk = (lane >> 4) & 1;
    const unsigned plw = (unsigned)(size_t)pl;
    const unsigned koff = (unsigned)((r & 7) * VBLK + (r >> 3) * 256 + 16 * (h ^ ((r >> 3) & 1)));
    const unsigned voff = (unsigned)(2 * VTILE + (4 * h + tq) * VBLK + 32 * blk + 8 * tp);
#define ATT_PV(vaddr_, pb0_, pb1_) do { \
        { s16x4 t0, t1, t2, t3, t4, t5, t6, t7; \
          asm volatile("ds_read_b64_tr_b16 %0, %8 offset:0\n\tds_read_b64_tr_b16 %1, %8 offset:256\n\tds_read_b64_tr_b16 %2, %8 offset:64\n\tds_read_b64_tr_b16 %3, %8 offset:320\n\t" \
                       "ds_read_b64_tr_b16 %4, %8 offset:128\n\tds_read_b64_tr_b16 %5, %8 offset:384\n\tds_read_b64_tr_b16 %6, %8 offset:192\n\tds_read_b64_tr_b16 %7, %8 offset:448\n\t" \
                       "s_waitcnt lgkmcnt(0)" \
                       : "=&v"(t0), "=&v"(t1), "=&v"(t2), "=&v"(t3), "=&v"(t4), "=&v"(t5), "=&v"(t6), "=&v"(t7) : "v"(vaddr_) : "memory"); \
          o[0] = MFMA32(__builtin_shufflevector(t0, t1, 0, 1, 2, 3, 4, 5, 6, 7), pb0_, o[0]); o[1] = MFMA32(__builtin_shufflevector(t2, t3, 0, 1, 2, 3, 4, 5, 6, 7), pb0_, o[1]); \
          o[2] = MFMA32(__builtin_shufflevector(t4, t5, 0, 1, 2, 3, 4, 5, 6, 7), pb0_, o[2]); o[3] = MFMA32(__builtin_shufflevector(t6, t7, 0, 1, 2, 3, 4, 5, 6, 7), pb0_, o[3]); } \
        { s16x4 t0, t1, t2, t3, t4, t5, t6, t7; \
          asm volatile("ds_read_b64_tr_b16 %0, %8 offset:512\n\tds_read_b64_tr_b16 %1, %8 offset:768\n\tds_read_b64_tr_b16 %2, %8 offset:576\n\tds_read_b64_tr_b16 %3, %8 offset:832\n\t" \
                       "ds_read_b64_tr_b16 %4, %8 offset:640\n\tds_read_b64_tr_b16 %5, %8 offset:896\n\tds_read_b64_tr_b16 %6, %8 offset:704\n\tds_read_b64_tr_b16 %7, %8 offset:960\n\t" \
                       "s_waitcnt lgkmcnt(0)" \
                       : "=&v"(t0), "=&v"(t1), "=&v"(t2), "=&v"(t3), "=&v"(t4), "=&v"(t5), "=&v"(t6), "=&v"(t7) : "v"(vaddr_) : "memory"); \
          o[0] = MFMA32(__builtin_shufflevector(t0, t1, 0, 1, 2, 3, 4, 5, 6, 7), pb1_, o[0]); o[1] = MFMA32(__builtin_shufflevector(t2, t3, 0, 1, 2, 3, 4, 5, 6, 7), pb1_, o[1]); \
          o[2] = MFMA32(__builtin_shufflevector(t4, t5, 0, 1, 2, 3, 4, 5, 6, 7), pb1_, o[2]); o[3] = MFMA32(__builtin_shufflevector(t6, t7, 0, 1, 2, 3, 4, 5, 6, 7), pb1_, o[3]); } } while (0)
    u32x4 pendA = {0u, 0u, 0u, 0u}, pendB = {0u, 0u, 0u, 0u}; bool pend = false; unsigned pendaddr = 0u;
#pragma unroll 1
    for (int c = 0; c < NS; ++c, ++g) {
        asm volatile("s_waitcnt vmcnt(0)" ::: "memory");
        __builtin_amdgcn_s_barrier();
        asm volatile("" ::: "memory");
        if (pend) { ATT_PV(pendaddr, __builtin_bit_cast(bf16x8, pendA), __builtin_bit_cast(bf16x8, pendB)); pend = false; }
        if (c + 1 < NS) { if (ATT_CVALID(c + 1)) ATT_DMA(c + 1, (g + 1) & 1); }
        else if (nu >= 0) attn_prefetch0<NA>(p, nu, sub, lane, dl + ((g + 1) & 1) * VTILE);
        bool use;
        int cl = 0;
        if (!NA) { cl = c - sub; use = ATT_CVALID(c) && cl >= 0 && cl <= 4; }
        else { const int krow = R0 + c; use = (krow >= ua) && (krow <= ub); }
        if (!use) continue;
        const unsigned slot = (unsigned)(g & 1) * VTILE;
        bf16x8 kf[8];
        asm volatile("ds_read_b128 %0, %8 offset:0\n\tds_read_b128 %1, %8 offset:32\n\tds_read_b128 %2, %8 offset:64\n\tds_read_b128 %3, %8 offset:96\n\t"
                     "ds_read_b128 %4, %8 offset:128\n\tds_read_b128 %5, %8 offset:160\n\tds_read_b128 %6, %8 offset:192\n\tds_read_b128 %7, %8 offset:224\n\t"
                     "s_waitcnt lgkmcnt(0)"
                     : "=&v"(kf[0]), "=&v"(kf[1]), "=&v"(kf[2]), "=&v"(kf[3]), "=&v"(kf[4]), "=&v"(kf[5]), "=&v"(kf[6]), "=&v"(kf[7])
                     : "v"(plw + slot + koff) : "memory");
        f32x16 s;
#pragma unroll
        for (int i = 0; i < 16; ++i) s[i] = 0.f;
#pragma unroll
        for (int kk = 0; kk < 8; ++kk) s = MFMA32(kf[kk], qf[kk], s);
        float cm = -1e30f;
#pragma unroll
        for (int i = 0; i < 16; ++i) {
            const int kr = (i & 3) + 8 * (i >> 2) + 4 * h;
            bool valid; float sv = s[i];
            if (!NA) { const int dj = 32 * cl + kr - r; valid = (dj >= 0) && (dj <= 128); if (cl >= 1 && cl <= 3) valid = true; }
            else { const int krow = R0 + c, kcol = kstart + kr;
                valid = (krow >= rsq) && (krow < rsq + 8) && (kcol >= csq) && (kcol < csq + 16);
                const int ro = clampi(krow - iq + 7, 0, 14), co = clampi(kcol - cq + 15, 0, 30); sv += bl[ro * 31 + co]; }
            sv = valid ? sv : -1e30f; s[i] = sv; cm = fmaxf(cm, sv);
        }
        cm = fmaxf(cm, __shfl_xor(cm, 32));
        const float m_new = fmaxf(m_run, cm), alpha = __builtin_amdgcn_exp2f(m_run - m_new);
        float ps = 0.f;
#pragma unroll
        for (int i = 0; i < 16; ++i) { float pv = __builtin_amdgcn_exp2f(s[i] - m_new); if (NA) pv = (s[i] > -1e29f) ? pv : 0.f; s[i] = pv; ps += pv; }
        l_run = l_run * alpha + ps; m_run = m_new;
        if (__builtin_amdgcn_ballot_w64(alpha != 1.0f) != 0ull) {
#pragma unroll
            for (int db = 0; db < 4; ++db)
#pragma unroll
                for (int i = 0; i < 16; ++i) o[db][i] *= alpha;
        }
        u32x4 pw0, pw1;
        pw0.x = pk2(s[0], s[1]); pw0.y = pk2(s[2], s[3]); pw0.z = pk2(s[4], s[5]); pw0.w = pk2(s[6], s[7]);
        pw1.x = pk2(s[8], s[9]); pw1.y = pk2(s[10], s[11]); pw1.z = pk2(s[12], s[13]); pw1.w = pk2(s[14], s[15]);
        if (sub == 0) { ATT_PV(plw + slot + voff, __builtin_bit_cast(bf16x8, pw0), __builtin_bit_cast(bf16x8, pw1)); }
        else { pendA = pw0; pendB = pw1; pendaddr = plw + slot + voff; pend = true; }
    }
    if (pend) { ATT_PV(pendaddr, __builtin_bit_cast(bf16x8, pendA), __builtin_bit_cast(bf16x8, pendB)); pend = false; }
#undef ATT_PV
#undef ATT_DMA
#undef ATT_KBASE
#undef ATT_CVALID
    LDS_WAIT();
    __builtin_amdgcn_s_barrier();
    asm volatile("" ::: "memory");
    const float lt = l_run + __shfl_xor(l_run, 32), inv = 1.0f / lt;
    const bool toH = NA || MG;
    bf16_t* dst = NA ? (bf16_t*)(p.ws + OFF_H) + 1024 + head * 128 : (MG ? (bf16_t*)(p.ws + OFF_H) + head * 128 : (bf16_t*)(p.ws + OFF_PART) + (size_t)pidx * MTOK * 1024 + head * 128);
    const int dpitch = toH ? DM : 1024;
    LAS unsigned char* sg = pl + (sub ? 0 : 2 * VTILE) + ((g - 1) & 1) * VTILE;
#pragma unroll
    for (int db = 0; db < 4; ++db)
#pragma unroll
        for (int gq = 0; gq < 4; ++gq) {
            u32x2 w; w.x = pk2(o[db][4 * gq] * inv, o[db][4 * gq + 1] * inv); w.y = pk2(o[db][4 * gq + 2] * inv, o[db][4 * gq + 3] * inv);
            *(LAS u32x2*)(sg + r * 256 + (((4 * db + gq) ^ (r & 15)) * 16) + 8 * h) = w;
        }
    if (MG && h == 0) { f32x2 ml3 = {m_run, lt}; *(LAS f32x2*)(sg + 8192 + r * 8) = ml3; }
    LDS_WAIT();
    { const int qr2 = lane >> 4;
#pragma unroll 4
      for (int t = 0; t < 8; ++t) {
          const int rr = 4 * t + qr2;
          int qrow2;
          if (!NA) qrow2 = b * SEQ + (((lq + rr) << dsh) + z); else qrow2 = b * SEQ + (iq - (r >> 4) + (rr >> 4)) * 64 + (cq - (r & 15)) + (rr & 15);
          u32x4 v = *(const LAS u32x4*)(sg + rr * 256 + (((lane & 15) ^ (rr & 15)) * 16));
          if (MG) {
              const f32x2 m3 = *(const LAS f32x2*)(sg + 8192 + rr * 8);
              const float* mlp = (const float*)(p.ws + OFF_ML);
              const f32x2 ma = *(const f32x2*)(mlp + (((size_t)qrow2) * 8 + head) * 2), mb = *(const f32x2*)(mlp + (((size_t)MTOK + qrow2) * 8 + head) * 2);
              const bf16_t* part = (const bf16_t*)(p.ws + OFF_PART);
              const u32x4 oa = *(const u32x4*)(part + (size_t)qrow2 * 1024 + head * 128 + (lane & 15) * 8);
              const u32x4 ob = *(const u32x4*)(part + ((size_t)MTOK + qrow2) * 1024 + head * 128 + (lane & 15) * 8);
              const float mm = fmaxf(ma[0], fmaxf(mb[0], m3[0]));
              const float wa = ma[1] * __builtin_amdgcn_exp2f(ma[0] - mm), wb = mb[1] * __builtin_amdgcn_exp2f(mb[0] - mm), w3 = m3[1] * __builtin_amdgcn_exp2f(m3[0] - mm);
              const float winv = 1.0f / (wa + wb + w3);
#pragma unroll
              for (int e = 0; e < 4; ++e) {
                  const float lo = (wa * bf_lo(oa[e]) + wb * bf_lo(ob[e]) + w3 * bf_lo(v[e])) * winv;
                  const float hi = (wa * bf_hi(oa[e]) + wb * bf_hi(ob[e]) + w3 * bf_hi(v[e])) * winv;
                  v[e] = pk2(lo, hi);
              }
          }
          *(u32x4*)(dst + (size_t)qrow2 * dpitch + (lane & 15) * 8) = v;
      }
    }
    LDS_WAIT();
    if (!NA && !MG && h == 0) { f32x2 ml = {m_run, lt}; *(f32x2*)((float*)(p.ws + OFF_ML) + (((size_t)pidx * MTOK + qrow) * 8 + head) * 2) = ml; }
}

__device__ __forceinline__ void phase_attn(const Params& p, int l, int stage, LAS unsigned char* lds, const int tid, const int bid) {
    const int lane = tid & 63, wave = __builtin_amdgcn_readfirstlane(tid >> 6), sub = wave >> 2, pairi = wave & 3;
    LAS unsigned char* pl = lds + pairi * PAIR_LDS;
    const int x = bid & 7, j = bid >> 3, ul = j * 4 + pairi;
    int g = 0;
#define ATT_UD(bh, pp) ((((bh) * 3 + (pp)) << 7) | ul)
#define ATT_UN(i) ((((i) * 8 + x) << 7) | ul)
    if (stage == 0) {
#pragma unroll 1
        for (int i = 0; i < 8; ++i) attn_pair_unit<0, 0>(p, l, ATT_UD((i >> 1) * 8 + x, i & 1), pl, sub, lane, g, i == 0, i < 7 ? ATT_UD(((i + 1) >> 1) * 8 + x, (i + 1) & 1) : -1);
    } else {
#pragma unroll 1
        for (int i = 0; i < 4; ++i) attn_pair_unit<0, 1>(p, l, ATT_UD(i * 8 + x, 2), pl, sub, lane, g, i == 0, i < 3 ? ATT_UD((i + 1) * 8 + x, 2) : -1);
#pragma unroll 1
        for (int i = 0; i < 4; ++i) attn_pair_unit<1, 0>(p, l, ATT_UN(i), pl, sub, lane, g, i == 0, i < 3 ? ATT_UN(i + 1) : -1);
    }
#undef ATT_UD
#undef ATT_UN
}

#define XB_TMO      128
#define XB_XCNT(j)  (256  + 64 * (j))
#define XB_XSUB(j)  (1280 + 64 * (j))
#define XB_XGEN(j)  (2304 + 64 * (j))
#define XB_TOP      3328
#define XB_TOPGEN   3392
#define XCD_BAR_WORDS 3456
#define XB_SPIN_CAP (1u << 22)
__device__ __forceinline__ unsigned xb_ld(unsigned* p)              { return __hip_atomic_load(p, __ATOMIC_RELAXED, __HIP_MEMORY_SCOPE_AGENT); }
__device__ __forceinline__ unsigned xb_add(unsigned* p, unsigned v) { return __hip_atomic_fetch_add(p, v, __ATOMIC_RELAXED, __HIP_MEMORY_SCOPE_AGENT); }
__device__ __forceinline__ unsigned xb_xcc_id() { return (unsigned)__builtin_amdgcn_s_getreg((3 << 11) | 20) & 0xFu; }
#define XB_SPIN(cond, bar) do { unsigned _sp = 0; while (cond) { __builtin_amdgcn_s_sleep(1); \
    if ((++_sp & 255u) == 0u) { if (xb_ld(&(bar)[XB_TMO])) break; if (_sp > XB_SPIN_CAP) { atomicAdd(&(bar)[XB_TMO], 1u); break; } } } } while (0)
__device__ __forceinline__ void xcd_barrier_post(unsigned* bar) {
    if (threadIdx.x == 0) (void)xb_add(&bar[XB_XCNT(xb_xcc_id())], 1u);
}
__device__ __forceinline__ void xcd_barrier_complete(unsigned* bar, unsigned x, unsigned& nloc, unsigned& nx) {
    const unsigned G = gridDim.x * gridDim.y * gridDim.z;
    unsigned sum, cnt, mine, sp = 0u;
    for (;;) {
        sum = 0u; cnt = 0u; mine = 0u;
#pragma unroll
        for (unsigned j = 0; j < 16; ++j) { const unsigned c = xb_ld(&bar[XB_XCNT(j)]); sum += c; cnt += (c > 0u) ? 1u : 0u; mine = (j == x) ? c : mine; }
        if (sum == G) break;
        __builtin_amdgcn_s_sleep(1);
        if ((++sp & 255u) == 0u) { if (xb_ld(&bar[XB_TMO])) break; if (sp > XB_SPIN_CAP) { atomicAdd(&bar[XB_TMO], 1u); break; } }
    }
    nloc = mine > 0u ? mine : 1u; nx = cnt > 0u ? cnt : 1u;
}
__device__ __forceinline__ void xcd_barrier(unsigned* bar, volatile LAS unsigned* st) {
    asm volatile("s_waitcnt vmcnt(0)" ::: "memory");
    __syncthreads();
    if (threadIdx.x == 0) {
        const unsigned x = xb_xcc_id();
        __builtin_amdgcn_s_waitcnt(0);
        unsigned nloc = st[0], nx = st[1];
        if (nloc == 0u) { xcd_barrier_complete(bar, x, nloc, nx); st[0] = nloc; st[1] = nx; }
        const unsigned old = xb_add(&bar[XB_XSUB(x)], 1u);
        const unsigned gen = old / nloc;
        if (old + 1u == (gen + 1u) * nloc) {
            __builtin_amdgcn_fence(__ATOMIC_RELEASE, "agent");
            asm volatile("s_waitcnt vmcnt(0)" ::: "memory");
            const unsigned og = xb_add(&bar[XB_TOP], 1u);
            const unsigned tg = og / nx;
            if (og + 1u == (tg + 1u) * nx) xb_add(&bar[XB_TOPGEN], 1u);
            else XB_SPIN(xb_ld(&bar[XB_TOPGEN]) == tg, bar);
            __builtin_amdgcn_fence(__ATOMIC_ACQUIRE, "agent");
            xb_add(&bar[XB_XGEN(x)], 1u);
            asm volatile("s_waitcnt vmcnt(0)" ::: "memory");
        } else {
            XB_SPIN(xb_ld(&bar[XB_XGEN(x)]) == gen, bar);
            __builtin_amdgcn_fence(__ATOMIC_ACQUIRE, "agent");
            asm volatile("s_waitcnt vmcnt(0)" ::: "memory");
        }
    }
    __syncthreads();
}

constexpr int NPHASES = 17;

typedef const __attribute__((address_space(4))) Params* ParamsK;
__device__ __forceinline__ void run_phase(int ph, LAS unsigned char* lds) {
    ParamsK pp = (ParamsK)__builtin_amdgcn_kernarg_segment_ptr();
    asm volatile("" : "+s"(pp));
    int tid = threadIdx.x, bid = blockIdx.x;
    asm volatile("" : "+v"(tid)); asm volatile("" : "+s"(bid));
    if (ph == 0) {
        Params p{}; p.ws = pp->ws; p.c = pp->c; p.w_ada = pp->w_ada; p.b_ada = pp->b_ada; p.w_in = pp->w_in; p.w_out = pp->w_out; p.w_mi = pp->w_mi; p.w_mo = pp->w_mo;
        rope_table(p, tid, bid);
        phase_mod(p, lds, tid, bid);
        convert_weights(p, 0, lds, tid, bid);
        return;
    }
    const int l = (ph - 1) >> 3, s = (ph - 1) & 7;
    pg8::StaticOrder S;
    switch (s) {
    case 0: {
        Params p{}; p.ws = pp->ws;
        if (l == 1) { p.w_in = pp->w_in; p.w_out = pp->w_out; p.w_mi = pp->w_mi; p.w_mo = pp->w_mo; convert_weights(p, 1, lds, tid, bid); }
        if (l == 0) phase_norm<false>(pp->x, (bf16_t*)(p.ws + OFF_H), pp->ln1, (const float*)(p.ws + OFF_MOD), 0, 2048, tid, bid);
        else phase_norm<true>(pp->out, (bf16_t*)(p.ws + OFF_H), pp->ln1 + DM, (const float*)(p.ws + OFF_MOD) + (size_t)4 * 12288, 0, 2048, tid, bid);
    } break;
    case 1: {
        unsigned char* ws = pp->ws;
        pg8::Gemm g{(const bf16_t*)(ws + OFF_H), (const bf16_t*)(ws + OFF_WT_IN), MTOK, NQKV, DM};
        S.init(MTOK, NQKV, gridDim.x, bid);
        pg8::EpiQKV E{(bf16_t*)(ws + OFF_BIG), pp->qnd + l * 128, pp->knd + l * 128, pp->qnn + l * 128, pp->knn + l * 128, (const float*)(ws + OFF_ROPE), (LAS float*)(lds + 131072)};
        pg8::gemm_phase(lds, g, S, E, tid);
    } break;
    case 2: { Params p{}; p.ws = pp->ws; p.rpb = pp->rpb; phase_attn(p, l, 0, lds, tid, bid); } break;
    case 3: { Params p{}; p.ws = pp->ws; p.rpb = pp->rpb; phase_attn(p, l, 1, lds, tid, bid); } break;
    case 4: {
        unsigned char* ws = pp->ws;
        pg8::Gemm g{(const bf16_t*)(ws + OFF_H), (const bf16_t*)(ws + OFF_WT_OUT), MTOK, DM, DM};
        S.init(MTOK, DM, gridDim.x, bid);
        const float* gate = (const float*)(ws + OFF_MOD) + (size_t)l * 4 * 12288 + 4096;
        if (l == 0) { pg8::EpiResid<false, true> E{ws + OFF_PART, pp->x, gate}; pg8::gemm_phase(lds, g, S, E, tid); }
        else { pg8::EpiResid<true, true> E{ws + OFF_PART, pp->out, gate}; pg8::gemm_phase(lds, g, S, E, tid); }
    } break;
    case 5: {
        unsigned char* ws = pp->ws;
        phase_norm<true>(ws + OFF_PART, (bf16_t*)(ws + OFF_H), pp->ln2 + l * DM, (const float*)(ws + OFF_MOD) + (size_t)l * 4 * 12288, 6144, 8192, tid, bid);
    } break;
    case 6: {
        unsigned char* ws = pp->ws;
        pg8::Gemm g{(const bf16_t*)(ws + OFF_H), (const bf16_t*)(ws + OFF_WT_MI), MTOK, DFF, DM};
        S.init(MTOK, DFF, gridDim.x, bid);
        pg8::EpiRelu2 E{(bf16_t*)(ws + OFF_BIG), DFF};
        pg8::gemm_phase(lds, g, S, E, tid);
    } break;
    case 7: {
        unsigned char* ws = pp->ws;
        pg8::Gemm g{(const bf16_t*)(ws + OFF_BIG), (const bf16_t*)(ws + OFF_WT_MO), MTOK, DM, DFF};
        S.init(MTOK, DM, gridDim.x, bid);
        const float* gate = (const float*)(ws + OFF_MOD) + (size_t)l * 4 * 12288 + 10240;
        if (l == 0) { pg8::EpiResid<true, true> E{pp->out, ws + OFF_PART, gate}; pg8::gemm_phase(lds, g, S, E, tid); }
        else { pg8::EpiResid<true, false> E{pp->out, ws + OFF_PART, gate}; pg8::gemm_phase(lds, g, S, E, tid); }
    } break;
    }
}

__global__ void __launch_bounds__(512, 2) hybrid_fwd(Params p, int ph_lo, int ph_hi) {
    extern __shared__ __attribute__((aligned(16))) unsigned char shm[];
    LAS unsigned char* lds = (LAS unsigned char*)shm;
    volatile LAS unsigned* st = (volatile LAS unsigned*)(lds + LDS_BYTES - 16);
    unsigned* bar = (unsigned*)(p.ws + OFF_BAR);
    const bool multi = (ph_hi - ph_lo) > 1;
    if (multi) {
        if (threadIdx.x == 0) { st[0] = 0u; st[1] = 0u; }
        xcd_barrier_post(bar);
    }
    if (ph_lo < 0) cg::this_grid().sync();
    for (int ph = ph_lo; ph < ph_hi; ++ph) {
        run_phase(ph, lds);
        if (ph + 1 < ph_hi) { unsigned* b2 = bar; asm volatile("" : "+s"(b2)); xcd_barrier(b2, st); }
    }
}

extern "C" void kernel_launch(void* const* d_in, const int* in_sizes, int n_in, void* d_out, int out_size, void* d_ws, size_t ws_size, hipStream_t stream) {
    static int ready = 0;
    if (!ready) {
        if (n_in != 15 || ws_size < WS_END) { fprintf(stderr, "kernel_launch: unexpected inputs (n_in %d, ws %zu, need %zu)\n", n_in, ws_size, (size_t)WS_END); ready = -1; return; }
        if (hipFuncSetAttribute((const void*)hybrid_fwd, hipFuncAttributeMaxDynamicSharedMemorySize, LDS_BYTES) != hipSuccess) { fprintf(stderr, "kernel_launch: hipFuncSetAttribute failed\n"); ready = -1; return; }
        ready = 1;
    }
    if (ready < 0) return;
    Params p{};
    p.x = (const float*)d_in[0]; p.c = (const float*)d_in[1]; p.ln1 = (const float*)d_in[2]; p.w_ada = (const float*)d_in[3]; p.b_ada = (const float*)d_in[4];
    p.w_in = (const float*)d_in[5]; p.qnd = (const float*)d_in[6]; p.knd = (const float*)d_in[7]; p.qnn = (const float*)d_in[8]; p.knn = (const float*)d_in[9];
    p.rpb = (const float*)d_in[10]; p.w_out = (const float*)d_in[11]; p.ln2 = (const float*)d_in[12]; p.w_mi = (const float*)d_in[13]; p.w_mo = (const float*)d_in[14];
    p.out = (float*)d_out; p.ws = (unsigned char*)d_ws;
    const int grid = 256;
    if (hipMemsetAsync((unsigned char*)d_ws + OFF_BAR, 0, 16384, stream) != hipSuccess) { fprintf(stderr, "kernel_launch: hipMemsetAsync of the barrier words failed\n"); return; }
#if MK_MULTI
    for (int ph = 0; ph < NPHASES; ++ph) {
        hipLaunchKernelGGL(hybrid_fwd, dim3(grid), dim3(512), LDS_BYTES, stream, p, ph, ph + 1);
    }
#else
    int ph_lo = 0, ph_hi = NPHASES;
    void* args[] = {&p, &ph_lo, &ph_hi};
    hipError_t e = hipLaunchCooperativeKernel((const void*)hybrid_fwd, dim3(grid), dim3(512), args, LDS_BYTES, stream);
    if (e != hipSuccess) fprintf(stderr, "cooperative launch failed: %s\n", hipGetErrorString(e));
#endif
}
```

```cpp
#include <hip/hip_runtime.h>
#include <hip/hip_cooperative_groups.h>
#include <cstdio>
#include <cstdint>
namespace cg = cooperative_groups;

#ifndef MK_MULTI
#define MK_MULTI 0
#endif

#define LAS __attribute__((address_space(3)))
typedef unsigned short bf16_t;
typedef short bf16x8 __attribute__((ext_vector_type(8)));
typedef short s16x4 __attribute__((ext_vector_type(4)));
typedef float f32x2 __attribute__((ext_vector_type(2)));
typedef float f32x4 __attribute__((ext_vector_type(4)));
typedef float f32x16 __attribute__((ext_vector_type(16)));
typedef unsigned u32x2 __attribute__((ext_vector_type(2)));
typedef unsigned u32x4 __attribute__((ext_vector_type(4)));
typedef __bf16 bf16x2_t __attribute__((ext_vector_type(2)));

constexpr int MTOK = 32768, DM = 2048, SEQ = 8192, NQKV = 6144, DFF = 8192;
constexpr int LDS_BYTES = 151552 + 16;
constexpr float QSCALE = 0.08838834764831845f * 1.4426950408889634f;
constexpr float EPSN = 1e-6f;

constexpr size_t OFF_WT_IN = 0;
constexpr size_t OFF_WT_OUT = OFF_WT_IN + (size_t)NQKV * DM * 2;
constexpr size_t OFF_WT_MI = OFF_WT_OUT + (size_t)DM * DM * 2;
constexpr size_t OFF_WT_MO = OFF_WT_MI + (size_t)DFF * DM * 2;
constexpr size_t OFF_MOD = OFF_WT_MO + (size_t)DM * DFF * 2;
constexpr size_t OFF_ROPE = OFF_MOD + (size_t)2 * 4 * 12288 * 4;
constexpr size_t OFF_H = OFF_ROPE + (size_t)SEQ * 32 * 4;
constexpr size_t OFF_BIG = OFF_H + (size_t)MTOK * DM * 2;
constexpr size_t OFF_PART = OFF_BIG + (size_t)MTOK * DFF * 2;
constexpr size_t OFF_ML = OFF_PART + (size_t)3 * MTOK * 1024 * 2;
constexpr size_t OFF_BAR = OFF_ML + (size_t)3 * MTOK * 8 * 8;
constexpr size_t WS_END = OFF_BAR + 16384;

struct Params {
    const float *x, *c, *ln1, *w_ada, *b_ada, *w_in, *qnd, *knd, *qnn, *knn, *rpb, *w_out, *ln2, *w_mi, *w_mo;
    float* out;
    unsigned char* ws;
};

__device__ __forceinline__ unsigned pk2(float lo, float hi) { f32x2 v = {lo, hi}; return __builtin_bit_cast(unsigned, __builtin_convertvector(v, bf16x2_t)); }
__device__ __forceinline__ float bf_lo(unsigned w) { return __uint_as_float(w << 16); }
__device__ __forceinline__ float bf_hi(unsigned w) { return __uint_as_float(w & 0xffff0000u); }
__device__ __forceinline__ int clampi(int v, int lo, int hi) { return v < lo ? lo : (v > hi ? hi : v); }

namespace pg8 {
constexpr int BM = 256, BK = 64, HALF = 128, HTB = HALF * BK * 2, STAGE_BYTES = 8 * HTB, NXCD = 8, WGM = 8;
__host__ __device__ __forceinline__ int lds_byte(int r, int c) { const int st = (r >> 4) * 2 + (c >> 5), rr = r & 15, cc = c & 31, ob = rr * 64 + cc * 2; return st * 1024 + (ob ^ (((ob >> 9) & 1) << 5)); }
__host__ __device__ __forceinline__ void stage_rc(int b, int& R, int& C) { const int st = b / 1024, sb = b % 1024, swz = sb ^ (((sb >> 9) & 1) << 5); R = (st >> 1) * 16 + swz / 64; C = (st & 1) * 32 + (swz % 64) / 2; }
__host__ __device__ __forceinline__ int perm32(int rho) { const int n = rho >> 4, i = rho & 15; return 8 * (i >> 2) + 4 * n + (i & 3); }

struct Unit { int pm, pn; };
struct Gemm { const bf16_t* A; const bf16_t* Bt; int M, N, K; };

struct StaticOrder {
    int nM, nN, nwg, G, c, wgm;
    __device__ void init(int M, int N, int G_, int c_, int wgm_ = WGM) { nM = M / BM; nN = N / BM; nwg = nM * nN; G = G_; c = c_; wgm = wgm_; }
    __device__ bool next(int i, Unit& u) const {
        const long L = (long)i * G + c; if (L >= nwg) return false;
        int wgid = (int)L; { const int q = nwg / NXCD, r = nwg % NXCD, xcd = wgid % NXCD, off = wgid / NXCD; wgid = (xcd < r ? xcd * (q + 1) : r * (q + 1) + (xcd - r) * q) + off; }
        const int nig = wgm * nN, gid = wgid / nig, fm = gid * wgm, gsz = (nM - fm) < wgm ? (nM - fm) : wgm;
        u.pm = fm + ((wgid % nig) % gsz); u.pn = (wgid % nig) / gsz; return true;
    }
};


template <bool RB, bool OB>
struct EpiResid {
    static constexpr bool PERM = true;
    void* out; const void* resid; const float* gate;
    __device__ __forceinline__ void operator()(const f32x4 (&acc)[2][2][4][2], const Unit& u, int wr, int wc, int fr, int fq) const {
        asm volatile("" : "+v"(fr), "+v"(fq));
        const int row0 = u.pm * BM + wr * 64 + fr, col0 = u.pn * BM + wc * 32 + 8 * fq;
        const float* gp = gate + (size_t)(u.pm >> 5) * 12288 + col0;
        f32x4 gv[2][2];
#pragma unroll
        for (int bj = 0; bj < 2; ++bj)
#pragma unroll
            for (int n = 0; n < 2; ++n) gv[bj][n] = *(const f32x4*)(gp + bj * HALF + 4 * n);
#pragma unroll
        for (int ai = 0; ai < 2; ++ai)
#pragma unroll
            for (int m = 0; m < 4; ++m) {
                const size_t ro = (size_t)(row0 + ai * HALF + m * 16) * DM + col0;
#pragma unroll
                for (int bj = 0; bj < 2; ++bj) {
                    f32x4 r0, r1;
                    if (RB) { const u32x4 rw = *(const u32x4*)((const bf16_t*)resid + ro + bj * HALF);
                        r0 = (f32x4){bf_lo(rw.x), bf_hi(rw.x), bf_lo(rw.y), bf_hi(rw.y)}; r1 = (f32x4){bf_lo(rw.z), bf_hi(rw.z), bf_lo(rw.w), bf_hi(rw.w)}; }
                    else { r0 = *(const f32x4*)((const float*)resid + ro + bj * HALF); r1 = *(const f32x4*)((const float*)resid + ro + bj * HALF + 4); }
                    const f32x4 v0 = r0 + gv[bj][0] * acc[ai][bj][m][0], v1 = r1 + gv[bj][1] * acc[ai][bj][m][1];
                    if (OB) { u32x4 w; w.x = pk2(v0[0], v0[1]); w.y = pk2(v0[2], v0[3]); w.z = pk2(v1[0], v1[1]); w.w = pk2(v1[2], v1[3]); *(u32x4*)((bf16_t*)out + ro + bj * HALF) = w; }
                    else { *(f32x4*)((float*)out + ro + bj * HALF) = v0; *(f32x4*)((float*)out + ro + bj * HALF + 4) = v1; }
                }
            }
    }
};

struct EpiRelu2 {
    static constexpr bool PERM = true;
    bf16_t* O; int ldc;
    __device__ __forceinline__ void operator()(const f32x4 (&acc)[2][2][4][2], const Unit& u, int wr, int wc, int fr, int fq) const {
        asm volatile("" : "+v"(fr), "+v"(fq));
        const int row0 = u.pm * BM + wr * 64 + fr, col0 = u.pn * BM + wc * 32 + 8 * fq;
#pragma unroll
        for (int ai = 0; ai < 2; ++ai)
#pragma unroll
            for (int m = 0; m < 4; ++m) {
                bf16_t* rowp = O + (size_t)(row0 + ai * HALF + m * 16) * ldc + col0;
#pragma unroll
                for (int bj = 0; bj < 2; ++bj) {
                    f32x4 v0 = acc[ai][bj][m][0], v1 = acc[ai][bj][m][1];
#pragma unroll
                    for (int j = 0; j < 4; ++j) { const float a = fmaxf(v0[j], 0.f), b = fmaxf(v1[j], 0.f); v0[j] = a * a; v1[j] = b * b; }
                    u32x4 w; w.x = pk2(v0[0], v0[1]); w.y = pk2(v0[2], v0[3]); w.z = pk2(v1[0], v1[1]); w.w = pk2(v1[2], v1[3]);
                    *(u32x4*)(rowp + bj * HALF) = w;
                }
            }
    }
};

struct EpiQKV {
    static constexpr bool PERM = true;
    bf16_t* O; const float *qnd, *knd, *qnn, *knn; const float* rope; LAS float* T;
    __device__ __forceinline__ void operator()(const f32x4 (&acc)[2][2][4][2], const Unit& u, int wr, int wc, int fr, int fq) const {
        asm volatile("" : "+v"(fr), "+v"(fq));
        const int type = (u.pn >> 2) % 3, grp = u.pn / 12;
        const int row0 = u.pm * BM + wr * 64 + fr, col0 = u.pn * BM + wc * 32 + 8 * fq;
        if (type == 2) {
#pragma unroll
            for (int ai = 0; ai < 2; ++ai)
#pragma unroll
                for (int m = 0; m < 4; ++m) {
                    bf16_t* rowp = O + ((size_t)(2 * u.pn) * MTOK + (row0 + ai * HALF + m * 16)) * 128 + wc * 32 + 8 * fq;
#pragma unroll
                    for (int bj = 0; bj < 2; ++bj) { const f32x4 v0 = acc[ai][bj][m][0], v1 = acc[ai][bj][m][1];
                        u32x4 w; w.x = pk2(v0[0], v0[1]); w.y = pk2(v0[2], v0[3]); w.z = pk2(v1[0], v1[1]); w.w = pk2(v1[2], v1[3]); *(u32x4*)(rowp + (size_t)bj * MTOK * 128) = w; }
                }
            return;
        }
#pragma unroll
        for (int ai = 0; ai < 2; ++ai)
#pragma unroll
            for (int m = 0; m < 4; ++m)
#pragma unroll
                for (int bj = 0; bj < 2; ++bj) {
                    const f32x4 a = acc[ai][bj][m][0], b = acc[ai][bj][m][1];
                    float s = (a[0] * a[0] + a[1] * a[1]) + (a[2] * a[2] + a[3] * a[3]) + (b[0] * b[0] + b[1] * b[1]) + (b[2] * b[2] + b[3] * b[3]);
                    s += __shfl_xor(s, 16); s += __shfl_xor(s, 32);
                    if (fq == 0) T[((wr * 128 + ai * 64 + m * 16 + fr) * 2 + bj) * 4 + wc] = s;
                }
        asm volatile("s_waitcnt lgkmcnt(0)" ::: "memory"); __builtin_amdgcn_s_barrier(); asm volatile("" ::: "memory");
        const float *ga = qnd, *gb = knd, *gc = qnn, *gd = knn;
        asm volatile("" : "+s"(ga), "+s"(gb), "+s"(gc), "+s"(gd));
        const float* g = type == 0 ? (grp == 0 ? ga : gc) : (grp == 0 ? gb : gd);
        f32x4 gm[2];
#pragma unroll
        for (int n = 0; n < 2; ++n) gm[n] = *(const f32x4*)(g + wc * 32 + 8 * fq + 4 * n);
        const float mul = type == 0 ? QSCALE : 1.0f;
        const bool dorope = (grp == 0) && (wc == 0);
        const float sgn = (fq < 2) ? -1.0f : 1.0f;
#pragma unroll
        for (int ai = 0; ai < 2; ++ai)
#pragma unroll
            for (int m = 0; m < 4; ++m) {
                const int row = row0 + ai * HALF + m * 16;
                f32x4 cs[2] = {{1.f, 1.f, 1.f, 1.f}, {1.f, 1.f, 1.f, 1.f}}, sn[2] = {{0.f, 0.f, 0.f, 0.f}, {0.f, 0.f, 0.f, 0.f}};
                if (dorope) { const float* rp = rope + (size_t)(row & (SEQ - 1)) * 32 + 8 * (fq & 1);
                    cs[0] = *(const f32x4*)rp; cs[1] = *(const f32x4*)(rp + 4); sn[0] = *(const f32x4*)(rp + 16); sn[1] = *(const f32x4*)(rp + 20);
                    sn[0] = sn[0] * sgn; sn[1] = sn[1] * sgn; }
                bf16_t* rowp = O + ((size_t)(2 * u.pn) * MTOK + row) * 128 + wc * 32 + 8 * fq;
#pragma unroll
                for (int bj = 0; bj < 2; ++bj) {
                    const f32x4 t4 = *(const LAS f32x4*)(T + ((wr * 128 + ai * 64 + m * 16 + fr) * 2 + bj) * 4);
                    const float rstd = rsqrtf(((t4[0] + t4[1]) + (t4[2] + t4[3])) * (1.0f / 128.0f) + EPSN);
                    f32x4 v0 = acc[ai][bj][m][0] * rstd * gm[0], v1 = acc[ai][bj][m][1] * rstd * gm[1];
                    if (dorope) {
                        f32x4 p0, p1;
#pragma unroll
                        for (int e = 0; e < 4; ++e) { p0[e] = __shfl_xor(v0[e], 32); p1[e] = __shfl_xor(v1[e], 32); }
                        v0 = v0 * cs[0] + p0 * sn[0]; v1 = v1 * cs[1] + p1 * sn[1];
                    }
                    v0 = v0 * mul; v1 = v1 * mul;
                    u32x4 w; w.x = pk2(v0[0], v0[1]); w.y = pk2(v0[2], v0[3]); w.z = pk2(v1[0], v1[1]); w.w = pk2(v1[2], v1[3]);
                    *(u32x4*)(rowp + (size_t)bj * MTOK * 128) = w;
                }
            }
    }
};

template <class Epi>
__device__ __forceinline__ void gemm_phase(LAS unsigned char* lds, const Gemm g, const StaticOrder& S, const Epi& E, const int tid) {
    const int wid = __builtin_amdgcn_readfirstlane(tid >> 6), lane = tid & 63, wr = wid >> 2, wc = wid & 3, fr = lane & 15, fq = lane >> 4;
    const int K = g.K, nt = K / BK;
    unsigned voffA[2], voffB[2];
#pragma unroll
    for (int i = 0; i < 2; ++i) { int R, C; stage_rc(tid * 16 + i * 8192, R, C); const int Rb = Epi::PERM ? ((R & ~31) + perm32(R & 31)) : R;
        voffA[i] = (unsigned)(R * K + C) * 2u; voffB[i] = (unsigned)(Rb * K + C) * 2u; }
    const size_t kstep = (size_t)(BK * 2);
    const size_t hstep = (size_t)HALF * K * 2;
    const size_t tstep = 2 * hstep;
    const unsigned ldsw = (unsigned)wid * 1024u;
    const int aoff = lds_byte(wr * 64 + fr, fq * 8), boff = lds_byte(wc * 32 + fr, fq * 8);
#define PG8_SA(b, h) (((b) * 2 + (h)) * HTB)
#define PG8_SB(b, h) ((4 + (b) * 2 + (h)) * HTB)
#define PG8_STAGE(bufoff, gbase, voff) do { _Pragma("unroll") for (int _i = 0; _i < 2; ++_i) \
        __builtin_amdgcn_global_load_lds((const unsigned*)((const char*)(gbase) + (voff)[_i]), (LAS unsigned*)(lds + (bufoff) + ldsw + _i * 8192), 16, 0, 0); } while (0)
#define PG8_LDA(dst, b, h) do { _Pragma("unroll") for (int m = 0; m < 4; ++m) _Pragma("unroll") for (int k = 0; k < 2; ++k) dst[m][k] = *(const LAS bf16x8*)(lds + PG8_SA(b, h) + aoff + m * 2048 + k * 1024); } while (0)
#define PG8_LDB(dst, b, h) do { _Pragma("unroll") for (int n = 0; n < 2; ++n) _Pragma("unroll") for (int k = 0; k < 2; ++k) dst[n][k] = *(const LAS bf16x8*)(lds + PG8_SB(b, h) + boff + n * 2048 + k * 1024); } while (0)
#define PG8_MMA(ai, bj, At, Bt) do { __builtin_amdgcn_s_setprio(1); _Pragma("unroll") for (int m = 0; m < 4; ++m) _Pragma("unroll") for (int n = 0; n < 2; ++n) _Pragma("unroll") for (int k = 0; k < 2; ++k) \
        acc[ai][bj][m][n] = __builtin_amdgcn_mfma_f32_16x16x32_bf16(Bt[n][k], At[m][k], acc[ai][bj][m][n], 0, 0, 0); __builtin_amdgcn_s_setprio(0); } while (0)
#define PG8_WAIT_V(n) asm volatile("s_waitcnt vmcnt(" #n ")" ::: "memory")
#define PG8_WAIT_L(n) asm volatile("s_waitcnt lgkmcnt(" #n ")" ::: "memory")
#define PG8_BAR __builtin_amdgcn_s_barrier()
#define PG8_SCHED __builtin_amdgcn_sched_barrier(0)
    Unit cur, nxt; int ui = 0;
    if (!S.next(0, cur)) return;
    f32x4 acc[2][2][4][2];
#pragma unroll
    for (int a = 0; a < 2; ++a)
#pragma unroll
        for (int b = 0; b < 2; ++b)
#pragma unroll
            for (int m = 0; m < 4; ++m)
#pragma unroll
                for (int n = 0; n < 2; ++n) acc[a][b][m][n] = (f32x4){0.f, 0.f, 0.f, 0.f};
    bf16x8 At[4][2], B0[2][2], B1[2][2];
    const char* cA = (const char*)g.A + (size_t)cur.pm * tstep; const char* cB = (const char*)g.Bt + (size_t)cur.pn * tstep;
    PG8_STAGE(PG8_SB(0, 0), cB, voffB); PG8_STAGE(PG8_SA(0, 0), cA, voffA); PG8_STAGE(PG8_SB(0, 1), cB + hstep, voffB); PG8_STAGE(PG8_SA(0, 1), cA + hstep, voffA);
    if (wr == 1) PG8_BAR;
    PG8_WAIT_V(4); PG8_BAR;
    PG8_STAGE(PG8_SB(1, 0), cB + kstep, voffB); PG8_STAGE(PG8_SA(1, 0), cA + kstep, voffA); PG8_STAGE(PG8_SB(1, 1), cB + hstep + kstep, voffB);
    PG8_WAIT_V(6); PG8_BAR;
    for (;;) {
        const bool has_next = S.next(ui + 1, nxt);
        const char* nA = has_next ? (const char*)g.A + (size_t)nxt.pm * tstep : cA; const char* nB = has_next ? (const char*)g.Bt + (size_t)nxt.pn * tstep : cB;
        for (int t = 0; t < nt; t += 2) {
            const bool last = (t == nt - 2);
            const char* a1 = cA + (size_t)(t + 1) * kstep;
            const char* a2 = last ? nA : cA + (size_t)(t + 2) * kstep; const char* b2 = last ? nB : cB + (size_t)(t + 2) * kstep;
            const char* a3 = a2 + kstep; const char* b3 = b2 + kstep;
            PG8_LDB(B0, 0, 0); PG8_SCHED; PG8_LDA(At, 0, 0); PG8_STAGE(PG8_SA(1, 1), a1 + hstep, voffA);
            PG8_WAIT_L(8); PG8_BAR; PG8_WAIT_L(0); PG8_MMA(0, 0, At, B0); PG8_BAR; PG8_SCHED;
            PG8_LDB(B1, 0, 1); PG8_STAGE(PG8_SB(0, 0), b2, voffB);
            PG8_BAR; PG8_WAIT_L(0); PG8_MMA(0, 1, At, B1); PG8_BAR;
            PG8_LDA(At, 0, 1); PG8_STAGE(PG8_SA(0, 0), a2, voffA);
            PG8_BAR; PG8_WAIT_L(0); PG8_MMA(1, 0, At, B0); PG8_BAR; PG8_SCHED;
            PG8_STAGE(PG8_SB(0, 1), b2 + hstep, voffB);
            PG8_WAIT_V(6); PG8_BAR; PG8_MMA(1, 1, At, B1); PG8_BAR;
            PG8_LDB(B0, 1, 0); PG8_SCHED; PG8_LDA(At, 1, 0); PG8_STAGE(PG8_SA(0, 1), a2 + hstep, voffA);
            PG8_WAIT_L(8); PG8_BAR; PG8_WAIT_L(0); PG8_MMA(0, 0, At, B0); PG8_BAR; PG8_SCHED;
            PG8_LDB(B1, 1, 1); PG8_STAGE(PG8_SB(1, 0), b3, voffB);
            PG8_BAR; PG8_WAIT_L(0); PG8_MMA(0, 1, At, B1); PG8_BAR;
            PG8_LDA(At, 1, 1); PG8_STAGE(PG8_SA(1, 0), a3, voffA);
            PG8_BAR; PG8_WAIT_L(0); PG8_MMA(1, 0, At, B0); PG8_BAR; PG8_SCHED;
            PG8_STAGE(PG8_SB(1, 1), b3 + hstep, voffB);
            PG8_WAIT_V(6); PG8_BAR; PG8_MMA(1, 1, At, B1); PG8_BAR;
        }
        E(acc, cur, wr, wc, fr, fq);
        if (!has_next) break;
#pragma unroll
        for (int a = 0; a < 2; ++a)
#pragma unroll
            for (int b = 0; b < 2; ++b)
#pragma unroll
                for (int m = 0; m < 4; ++m)
#pragma unroll
                    for (int n = 0; n < 2; ++n) acc[a][b][m][n] = (f32x4){0.f, 0.f, 0.f, 0.f};
        cur = nxt; cA = nA; cB = nB; ++ui;
    }
    PG8_WAIT_V(0);
    if (wr == 0) PG8_BAR;
    PG8_BAR;
#undef PG8_SA
#undef PG8_SB
#undef PG8_STAGE
#undef PG8_LDA
#undef PG8_LDB
#undef PG8_MMA
#undef PG8_WAIT_V
#undef PG8_WAIT_L
#undef PG8_BAR
#undef PG8_SCHED
}
}

#define LDS_WAIT() asm volatile("s_waitcnt lgkmcnt(0)" ::: "memory")

__device__ __forceinline__ float wave_sum(float v) {
#pragma unroll
    for (int o = 1; o < 64; o <<= 1) v += __shfl_xor(v, o);
    return v;
}

__device__ __forceinline__ void transpose_item(const float* W, int K, int N, bf16_t* WT, LAS float* scr, int item, int lane) {
    const int nblk = N / 32, kb = item / nblk, nb = item % nblk, k0 = 64 * kb, n0 = 32 * nb;
#pragma unroll 8
    for (int i = 0; i < 32; ++i) { const int kk = 2 * i + (lane >> 5); scr[kk * 33 + (lane & 31)] = W[(size_t)(k0 + kk) * N + n0 + (lane & 31)]; }
    LDS_WAIT();
    const int c = lane & 7;
#pragma unroll
    for (int j = 0; j < 4; ++j) { const int n = (lane >> 3) + 8 * j; const LAS float* s = scr + (8 * c) * 33 + n;
        u32x4 o; o.x = pk2(s[0 * 33], s[1 * 33]); o.y = pk2(s[2 * 33], s[3 * 33]); o.z = pk2(s[4 * 33], s[5 * 33]); o.w = pk2(s[6 * 33], s[7 * 33]);
        *(u32x4*)(WT + (size_t)(n0 + n) * K + k0 + 8 * c) = o; }
    LDS_WAIT();
}

__device__ __forceinline__ void convert_weights(const Params& p, int l, LAS unsigned char* lds, const int tid, const int bid) {
    const int lane = tid & 63, wave = tid >> 6;
    LAS float* scr = (LAS float*)(lds + wave * 8704);
    const int gw = bid * 8 + wave, NGW = gridDim.x * 8;
    constexpr int I_IN = (DM / 64) * (NQKV / 32), I_OUT = (DM / 64) * (DM / 32), I_MI = (DM / 64) * (DFF / 32), I_MO = (DFF / 64) * (DM / 32);
    constexpr int NITEMS = I_IN + I_OUT + I_MI + I_MO;
    bf16_t* wt_in = (bf16_t*)(p.ws + OFF_WT_IN); bf16_t* wt_out = (bf16_t*)(p.ws + OFF_WT_OUT);
    bf16_t* wt_mi = (bf16_t*)(p.ws + OFF_WT_MI); bf16_t* wt_mo = (bf16_t*)(p.ws + OFF_WT_MO);
    for (int it = gw; it < NITEMS; it += NGW) {
        int r = it;
        if (r < I_IN) { transpose_item(p.w_in + (size_t)l * DM * NQKV, DM, NQKV, wt_in, scr, r, lane); continue; } r -= I_IN;
        if (r < I_OUT) { transpose_item(p.w_out + (size_t)l * DM * DM, DM, DM, wt_out, scr, r, lane); continue; } r -= I_OUT;
        if (r < I_MI) { transpose_item(p.w_mi + (size_t)l * DM * DFF, DM, DFF, wt_mi, scr, r, lane); continue; } r -= I_MI;
        transpose_item(p.w_mo + (size_t)l * DFF * DM, DFF, DM, wt_mo, scr, r, lane);
    }
}

__constant__ float c_inv_freq[16] = {1.0f, 0.44036660267178046f, 0.19392274474868576f, 0.08539710028576561f, 0.03760603093086393f, 0.016560440080994446f,
    0.007292664737217109f, 0.003211445994752591f, 0.001414213562373095f, 0.000622772421914596f, 0.0002742481756762073f, 0.00012076973741146504f,
    5.318295896944988e-05f, 2.341999896140934e-05f, 1.031338537721246e-05f, 4.5416704806078695e-06f};

__device__ __forceinline__ void rope_table(const Params& p, const int tid, const int bid) {
    float* rope = (float*)(p.ws + OFF_ROPE);
    const int gt = bid * 512 + tid, NT = gridDim.x * 512;
    for (int e = gt; e < SEQ * 16; e += NT) {
        const int pos = e >> 4, i = e & 15;
        const float ang = (float)pos * c_inv_freq[i];
        const double rev = (double)ang * 0.15915494309189533576888;
        const double fr = rev - __builtin_rint(rev);
        const float f = (float)fr;
        rope[pos * 32 + i] = __builtin_amdgcn_cosf(f);
        rope[pos * 32 + 16 + i] = __builtin_amdgcn_sinf(f);
    }
}

__device__ __forceinline__ void phase_mod(const Params& p, LAS unsigned char* lds, const int tid, const int bid) {
    LAS float* cact = (LAS float*)lds;
    LAS float* red = (LAS float*)(lds + 32768);
    float* mod = (float*)(p.ws + OFF_MOD);
    for (int i = tid; i < 4 * DM; i += 512) { const float v = p.c[i]; cact[i] = v / (1.0f + __expf(-v)); }
    __syncthreads();
    const int c4 = tid % 24, ks = tid / 24;
    for (int job = bid; job < 256; job += gridDim.x) {
        const int l = job >> 7, n0 = (job & 127) * 96;
        const float* W = p.w_ada + (size_t)l * DM * 12288 + n0 + c4 * 4;
        f32x4 a0 = {0.f, 0.f, 0.f, 0.f}, a1 = a0, a2 = a0, a3 = a0;
        if (ks < 21) {
            for (int k = ks; k < DM; k += 21) {
                const f32x4 w = *(const f32x4*)(W + (size_t)k * 12288);
                a0 += w * cact[k]; a1 += w * cact[DM + k]; a2 += w * cact[2 * DM + k]; a3 += w * cact[3 * DM + k];
            }
            LAS float* rp = red + ks * 384 + c4 * 4;
            *(LAS f32x4*)(rp) = a0; *(LAS f32x4*)(rp + 96) = a1; *(LAS f32x4*)(rp + 192) = a2; *(LAS f32x4*)(rp + 288) = a3;
        }
        __syncthreads();
        if (tid < 384) {
            const int b = tid / 96, n = tid % 96; float s = 0.f;
            for (int q = 0; q < 21; ++q) s += red[q * 384 + tid];
            mod[(size_t)(l * 4 + b) * 12288 + n0 + n] = s + p.b_ada[l * 12288 + n0 + n];
        }
        __syncthreads();
    }
}

template <bool XB>
__device__ __forceinline__ void phase_norm(const void* xin, bf16_t* H, const float* ln, const float* modl, int sh_off, int sc_off, const int tid, const int bid) {
    const int lane = tid & 63, wave = tid >> 6;
    const int gw = (gridDim.x == 256) ? ((bid & 7) * 256 + (bid >> 3) * 8 + wave) : (bid * 8 + wave), NGW = gridDim.x * 8;
    const int rpw = 16;
    for (int chunk = gw; chunk < MTOK / rpw; chunk += NGW) {
        const int row0 = chunk * rpw, b = row0 >> 13;
        f32x4 A[8], Bv[8];
#pragma unroll
        for (int q = 0; q < 8; ++q) {
            const int col = 8 * lane + 512 * (q >> 1) + 4 * (q & 1);
            const f32x4 lv = *(const f32x4*)(ln + col);
            const f32x4 sc = *(const f32x4*)(modl + (size_t)b * 12288 + sc_off + col);
            Bv[q] = *(const f32x4*)(modl + (size_t)b * 12288 + sh_off + col);
            A[q] = lv * (sc + 1.0f);
        }
        for (int r = 0; r < rpw; ++r) {
            f32x4 v[8]; float ss = 0.f;
            if (XB) {
                const bf16_t* xr = (const bf16_t*)xin + (size_t)(row0 + r) * DM + 8 * lane;
#pragma unroll
                for (int j = 0; j < 4; ++j) { const u32x4 w = *(const u32x4*)(xr + 512 * j);
                    v[2 * j] = (f32x4){bf_lo(w.x), bf_hi(w.x), bf_lo(w.y), bf_hi(w.y)}; v[2 * j + 1] = (f32x4){bf_lo(w.z), bf_hi(w.z), bf_lo(w.w), bf_hi(w.w)}; }
            } else {
                const float* xr = (const float*)xin + (size_t)(row0 + r) * DM + 8 * lane;
#pragma unroll
                for (int j = 0; j < 4; ++j) { v[2 * j] = *(const f32x4*)(xr + 512 * j); v[2 * j + 1] = *(const f32x4*)(xr + 512 * j + 4); }
            }
#pragma unroll
            for (int q = 0; q < 8; ++q) ss += (v[q][0] * v[q][0] + v[q][1] * v[q][1]) + (v[q][2] * v[q][2] + v[q][3] * v[q][3]);
            const float rstd = rsqrtf(wave_sum(ss) * (1.0f / DM) + EPSN);
            bf16_t* orow = H + (size_t)(row0 + r) * DM + 8 * lane;
#pragma unroll
            for (int j = 0; j < 4; ++j) { const f32x4 y0 = v[2 * j] * rstd * A[2 * j] + Bv[2 * j], y1 = v[2 * j + 1] * rstd * A[2 * j + 1] + Bv[2 * j + 1];
                u32x4 w; w.x = pk2(y0[0], y0[1]); w.y = pk2(y0[2], y0[3]); w.z = pk2(y1[0], y1[1]); w.w = pk2(y1[2], y1[3]); *(u32x4*)(orow + 512 * j) = w; }
        }
    }
}

#define MFMA32(a, b, c) __builtin_amdgcn_mfma_f32_32x32x16_bf16((a), (b), (c), 0, 0, 0)
constexpr int VBLK = 1056;
constexpr int VTILE = 8 * VBLK;
constexpr int PAIR_LDS = 4 * VTILE + 2048;

template <int NA>
__device__ __forceinline__ void attn_prefetch0(const Params& p, int u, int sub, int lane, LAS unsigned char* dst) {
    const bf16_t* QKV = (const bf16_t*)(p.ws + OFF_BIG);
    int b, head, kstride, kbase; bool valid;
    if (!NA) {
        const int qb = u & 127, rest = u >> 7, pidx = rest % 3, bh = rest / 3; b = bh >> 3; head = bh & 7;
        const int dsh = 2 * pidx, nq = 128 >> dsh, z = qb >> (7 - dsh), l0 = (qb & (nq - 1)) << 6;
        kstride = 1 << dsh; kbase = ((l0 - 64) << dsh) + z; valid = (l0 - 64) >= 0;
    } else {
        const int cb = u & 3, rq = (u >> 2) & 31, bh = u >> 7; b = bh >> 3; head = bh & 7;
        kstride = 1; kbase = clampi(4 * rq - 4, 0, 120) * 64 + clampi(16 * cb - 8, 0, 32); valid = true;
    }
    if (!valid) return;
    const int hs0 = (NA ? 24 : 0) + head;
    const bf16_t* gp = QKV + ((size_t)(hs0 + (sub ? 16 : 8)) * MTOK + b * SEQ + 8 * (lane >> 4) * kstride + kbase) * 128 + (((lane & 15) ^ (sub ? 0 : ((lane >> 4) & 1))) * 8);
    const size_t kstep = (size_t)kstride * 128;
#pragma unroll
    for (int t = 0; t < 8; ++t) { __builtin_amdgcn_global_load_lds((const unsigned*)gp, (LAS unsigned*)(dst + t * VBLK), 16, 0, 0); gp += kstep; asm volatile("" : "+v"(gp)); }
}

template <int NA, int MG>
__device__ __forceinline__ void attn_pair_unit(const Params& p, int l, int u, LAS unsigned char* pl, int sub, int lane, int& g, const bool own0, const int nu) {
    constexpr int NS = NA ? 11 : 6;
    const bf16_t* QKV = (const bf16_t*)(p.ws + OFF_BIG);
    const int r = lane & 31, h = lane >> 5;
    int b, head, qrow;
    int dsh = 0, z = 0, l0 = 0, L = 0, pidx = 0, lq = 0;
    int R0 = 0, Rlast = 0, kstart = 0, iq = 0, cq = 0, rsq = 0, csq = 0, ua = 0, ub = 0;
    if (!NA) {
        const int qb = u & 127, rest = u >> 7; pidx = rest % 3; const int bh = rest / 3; b = bh >> 3; head = bh & 7;
        dsh = 2 * pidx; L = SEQ >> dsh; const int nq = 128 >> dsh; z = qb >> (7 - dsh); l0 = (qb & (nq - 1)) << 6; lq = l0 + 32 * sub;
        qrow = b * SEQ + (((lq + r) << dsh) + z);
    } else {
        const int cb = u & 3, rq = (u >> 2) & 31; const int bh = u >> 7; b = bh >> 3; head = bh & 7;
        const int i0 = 4 * rq, iA = i0 + 2 * sub;
        R0 = clampi(i0 - 4, 0, 120); Rlast = clampi(i0 - 1, 0, 120) + 7;
        ua = clampi(iA - 4, 0, 120); ub = clampi(iA - 3, 0, 120) + 7;
        kstart = clampi(16 * cb - 8, 0, 32);
        iq = iA + (r >> 4); cq = 16 * cb + (r & 15); rsq = clampi(iq - 4, 0, 120); csq = clampi(cq - 8, 0, 48);
        qrow = b * SEQ + iq * 64 + cq;
    }
    const int hs0 = (NA ? 24 : 0) + head;
    const int kstride = NA ? 1 : (1 << dsh);
    const char* ubp = (const char*)(QKV + ((size_t)(hs0 + (sub ? 16 : 8)) * MTOK + b * SEQ) * 128);
    const unsigned vo = (unsigned)((8 * (lane >> 4) * kstride) * 128 + (((lane & 15) ^ (sub ? 0 : ((lane >> 4) & 1))) * 8)) * 2u;
    LAS unsigned char* dl = pl + (sub ? 2 * VTILE : 0);
#define ATT_KBASE(c) (NA ? ((R0 + (c)) * 64 + kstart) : (((l0 - 64 + 32 * (c)) << dsh) + z))
#define ATT_CVALID(c) (NA ? (R0 + (c) <= Rlast) : ((l0 - 64 + 32 * (c)) >= 0 && (l0 - 64 + 32 * (c)) < L))
#define ATT_DMA(c, slot) do { const char* gb_ = ubp + (size_t)ATT_KBASE(c) * 256; LAS unsigned char* lb_ = dl + (slot) * VTILE; \
        _Pragma("unroll") for (int t = 0; t < 8; ++t) __builtin_amdgcn_global_load_lds((const unsigned*)(gb_ + (size_t)(t * kstride) * 256 + vo), (LAS unsigned*)(lb_ + t * VBLK), 16, 0, 0); } while (0)
    LAS float* bl = (LAS float*)(pl + 4 * VTILE);
    if (own0 && ATT_CVALID(0)) ATT_DMA(0, g & 1);
    bf16x8 qf[8];
    { const bf16_t* qp = QKV + ((size_t)hs0 * MTOK + qrow) * 128 + 8 * h;
#pragma unroll
      for (int kk = 0; kk < 8; ++kk) qf[kk] = *(const bf16x8*)(qp + 16 * kk); }
    f32x16 o[4];
#pragma unroll
    for (int db = 0; db < 4; ++db)
#pragma unroll
        for (int i = 0; i < 16; ++i) o[db][i] = 0.f;
    float m_run = -1e30f, l_run = 0.f;
    const int i16 = lane & 15, tq = i16 >> 2, tp = i16 & 3, blk = (lane >> 4) & 1;
    const unsigned plw = (unsigned)(size_t)pl;
    const unsigned koff = (unsigned)((r & 7) * VBLK + (r >> 3) * 256 + 16 * (h ^ ((r >> 3) & 1)));
    const unsigned voff = (unsigned)(2 * VTILE + (4 * h + tq) * VBLK + 32 * blk + 8 * tp);
    for (int c = 0; c < NS; ++c, ++g) {
        asm volatile("s_waitcnt vmcnt(0)" ::: "memory");
        __builtin_amdgcn_s_barrier();
        asm volatile("" ::: "memory");
        if (c + 1 < NS) { if (ATT_CVALID(c + 1)) ATT_DMA(c + 1, (g + 1) & 1); }
        else if (nu >= 0) attn_prefetch0<NA>(p, nu, sub, lane, dl + ((g + 1) & 1) * VTILE);
        bool use;
        int cl = 0;
        if (!NA) { cl = c - sub; use = ATT_CVALID(c) && cl >= 0 && cl <= 4; }
        else { const int krow = R0 + c; use = (krow >= ua) && (krow <= ub); }
        if (!use) continue;
        const unsigned slot = (unsigned)(g & 1) * VTILE;
        bf16x8 kf[8];
        asm volatile("ds_read_b128 %0, %8 offset:0\n\tds_read_b128 %1, %8 offset:32\n\tds_read_b128 %2, %8 offset:64\n\tds_read_b128 %3, %8 offset:96\n\t"
                     "ds_read_b128 %4, %8 offset:128\n\tds_read_b128 %5, %8 offset:160\n\tds_read_b128 %6, %8 offset:192\n\tds_read_b128 %7, %8 offset:224\n\t"
                     "s_waitcnt lgkmcnt(0)"
                     : "=&v"(kf[0]), "=&v"(kf[1]), "=&v"(kf[2]), "=&v"(kf[3]), "=&v"(kf[4]), "=&v"(kf[5]), "=&v"(kf[6]), "=&v"(kf[7])
                     : "v"(plw + slot + koff) : "memory");
        f32x16 s;
#pragma unroll
        for (int i = 0; i < 16; ++i) s[i] = 0.f;
#pragma unroll
        for (int kk = 0; kk < 8; ++kk) s = MFMA32(kf[kk], qf[kk], s);
        float cm = -1e30f;
#pragma unroll
        for (int i = 0; i < 16; ++i) {
            const int kr = (i & 3) + 8 * (i >> 2) + 4 * h;
            bool valid; float sv = s[i];
            if (!NA) { const int dj = 32 * cl + kr - r; valid = (dj >= 0) && (dj <= 128); if (cl >= 1 && cl <= 3) valid = true; }
            else { const int krow = R0 + c, kcol = kstart + kr;
                valid = (krow >= rsq) && (krow < rsq + 8) && (kcol >= csq) && (kcol < csq + 16);
                const int ro = clampi(krow - iq + 7, 0, 14), co = clampi(kcol - cq + 15, 0, 30); sv += bl[ro * 31 + co]; }
            sv = valid ? sv : -1e30f; s[i] = sv; cm = fmaxf(cm, sv);
        }
        cm = fmaxf(cm, __shfl_xor(cm, 32));
        if (__builtin_amdgcn_ballot_w64(cm > m_run + 8.0f) != 0ull) {
            const float m_new = fmaxf(m_run, cm), alpha = __builtin_amdgcn_exp2f(m_run - m_new);
            l_run *= alpha; m_run = m_new;
#pragma unroll
            for (int db = 0; db < 4; ++db)
#pragma unroll
                for (int i = 0; i < 16; ++i) o[db][i] *= alpha;
        }
        float ps = 0.f;
#pragma unroll
        for (int i = 0; i < 16; ++i) { float pv = __builtin_amdgcn_exp2f(s[i] - m_run); if (NA) pv = (s[i] > -1e29f) ? pv : 0.f; s[i] = pv; ps += pv; }
        l_run += ps;
#pragma unroll
        for (int s2 = 0; s2 < 2; ++s2) {
            u32x4 pw; pw.x = pk2(s[8 * s2], s[8 * s2 + 1]); pw.y = pk2(s[8 * s2 + 2], s[8 * s2 + 3]); pw.z = pk2(s[8 * s2 + 4], s[8 * s2 + 5]); pw.w = pk2(s[8 * s2 + 6], s[8 * s2 + 7]);
            const bf16x8 pb = __builtin_bit_cast(bf16x8, pw);
            s16x4 t0, t1, t2, t3, t4, t5, t6, t7;
            asm volatile("ds_read_b64_tr_b16 %0, %8 offset:%9\n\tds_read_b64_tr_b16 %1, %8 offset:%10\n\tds_read_b64_tr_b16 %2, %8 offset:%11\n\tds_read_b64_tr_b16 %3, %8 offset:%12\n\t"
                         "ds_read_b64_tr_b16 %4, %8 offset:%13\n\tds_read_b64_tr_b16 %5, %8 offset:%14\n\tds_read_b64_tr_b16 %6, %8 offset:%15\n\tds_read_b64_tr_b16 %7, %8 offset:%16\n\t"
                         "s_waitcnt lgkmcnt(0)"
                         : "=&v"(t0), "=&v"(t1), "=&v"(t2), "=&v"(t3), "=&v"(t4), "=&v"(t5), "=&v"(t6), "=&v"(t7)
                         : "v"(plw + slot + voff), "i"((2 * s2) * 256), "i"((2 * s2 + 1) * 256), "i"((2 * s2) * 256 + 64), "i"((2 * s2 + 1) * 256 + 64),
                           "i"((2 * s2) * 256 + 128), "i"((2 * s2 + 1) * 256 + 128), "i"((2 * s2) * 256 + 192), "i"((2 * s2 + 1) * 256 + 192)
                         : "memory");
            o[0] = MFMA32(__builtin_shufflevector(t0, t1, 0, 1, 2, 3, 4, 5, 6, 7), pb, o[0]);
            o[1] = MFMA32(__builtin_shufflevector(t2, t3, 0, 1, 2, 3, 4, 5, 6, 7), pb, o[1]);
            o[2] = MFMA32(__builtin_shufflevector(t4, t5, 0, 1, 2, 3, 4, 5, 6, 7), pb, o[2]);
            o[3] = MFMA32(__builtin_shufflevector(t6, t7, 0, 1, 2, 3, 4, 5, 6, 7), pb, o[3]);
        }
    }
#undef ATT_DMA
#undef ATT_KBASE
#undef ATT_CVALID
    LDS_WAIT();
    __builtin_amdgcn_s_barrier();
    asm volatile("" ::: "memory");
    const float lt = l_run + __shfl_xor(l_run, 32), inv = 1.0f / lt;
    const bool toH = NA || MG;
    bf16_t* dst = NA ? (bf16_t*)(p.ws + OFF_H) + 1024 + head * 128 : (MG ? (bf16_t*)(p.ws + OFF_H) + head * 128 : (bf16_t*)(p.ws + OFF_PART) + (size_t)pidx * MTOK * 1024 + head * 128);
    const int dpitch = toH ? DM : 1024;
    LAS unsigned char* sg = pl + (sub ? 0 : 2 * VTILE) + ((g - 1) & 1) * VTILE;
#pragma unroll
    for (int db = 0; db < 4; ++db)
#pragma unroll
        for (int gq = 0; gq < 4; ++gq) {
            u32x2 w; w.x = pk2(o[db][4 * gq] * inv, o[db][4 * gq + 1] * inv); w.y = pk2(o[db][4 * gq + 2] * inv, o[db][4 * gq + 3] * inv);
            *(LAS u32x2*)(sg + r * 256 + (((4 * db + gq) ^ (r & 15)) * 16) + 8 * h) = w;
        }
    if (MG && h == 0) { f32x2 ml3 = {m_run, lt}; *(LAS f32x2*)(sg + 8192 + r * 8) = ml3; }
    LDS_WAIT();
    { const int qr2 = lane >> 4;
#pragma unroll 4
      for (int t = 0; t < 8; ++t) {
          const int rr = 4 * t + qr2;
          int qrow2;
          if (!NA) qrow2 = b * SEQ + (((lq + rr) << dsh) + z); else qrow2 = b * SEQ + (iq - (r >> 4) + (rr >> 4)) * 64 + (cq - (r & 15)) + (rr & 15);
          u32x4 v = *(const LAS u32x4*)(sg + rr * 256 + (((lane & 15) ^ (rr & 15)) * 16));
          if (MG) {
              const f32x2 m3 = *(const LAS f32x2*)(sg + 8192 + rr * 8);
              const float* mlp = (const float*)(p.ws + OFF_ML);
              const f32x2 ma = *(const f32x2*)(mlp + (((size_t)qrow2) * 8 + head) * 2), mb = *(const f32x2*)(mlp + (((size_t)MTOK + qrow2) * 8 + head) * 2);
              const bf16_t* part = (const bf16_t*)(p.ws + OFF_PART);
              const u32x4 oa = *(const u32x4*)(part + (size_t)qrow2 * 1024 + head * 128 + (lane & 15) * 8);
              const u32x4 ob = *(const u32x4*)(part + ((size_t)MTOK + qrow2) * 1024 + head * 128 + (lane & 15) * 8);
              const float mm = fmaxf(ma[0], fmaxf(mb[0], m3[0]));
              const float wa = ma[1] * __builtin_amdgcn_exp2f(ma[0] - mm), wb = mb[1] * __builtin_amdgcn_exp2f(mb[0] - mm), w3 = m3[1] * __builtin_amdgcn_exp2f(m3[0] - mm);
              const float winv = 1.0f / (wa + wb + w3);
#pragma unroll
              for (int e = 0; e < 4; ++e) {
                  const float lo = (wa * bf_lo(oa[e]) + wb * bf_lo(ob[e]) + w3 * bf_lo(v[e])) * winv;
                  const float hi = (wa * bf_hi(oa[e]) + wb * bf_hi(ob[e]) + w3 * bf_hi(v[e])) * winv;
                  v[e] = pk2(lo, hi);
              }
          }
          *(u32x4*)(dst + (size_t)qrow2 * dpitch + (lane & 15) * 8) = v;
      }
    }
    LDS_WAIT();
    if (!NA && !MG && h == 0) { f32x2 ml = {m_run, lt}; *(f32x2*)((float*)(p.ws + OFF_ML) + (((size_t)pidx * MTOK + qrow) * 8 + head) * 2) = ml; }
}

__device__ __forceinline__ void phase_attn(const Params& p, int l, int stage, LAS unsigned char* lds, const int tid, const int bid) {
    const int lane = tid & 63, wave = __builtin_amdgcn_readfirstlane(tid >> 6), sub = wave >> 2, pairi = wave & 3;
    LAS unsigned char* pl = lds + pairi * PAIR_LDS;
    const int x = bid & 7, j = bid >> 3, ul = j * 4 + pairi;
    int g = 0;
#define ATT_UD(bh, pp) ((((bh) * 3 + (pp)) << 7) | ul)
#define ATT_UN(i) ((((i) * 8 + x) << 7) | ul)
    if (stage == 0) {
#pragma unroll 1
        for (int i = 0; i < 8; ++i) attn_pair_unit<0, 0>(p, l, ATT_UD((i >> 1) * 8 + x, i & 1), pl, sub, lane, g, i == 0, i < 7 ? ATT_UD(((i + 1) >> 1) * 8 + x, (i + 1) & 1) : -1);
    } else {
#pragma unroll 1
        for (int i = 0; i < 4; ++i) attn_pair_unit<0, 1>(p, l, ATT_UD(i * 8 + x, 2), pl, sub, lane, g, i == 0, i < 3 ? ATT_UD((i + 1) * 8 + x, 2) : -1);
        {
          LAS float* bl = (LAS float*)(pl + 4 * VTILE); const float* rb = p.rpb + ((size_t)l * 8 + x) * 465;
          for (int i = lane; i < 465; i += 64) bl[i] = rb[i] * 1.4426950408889634f; LDS_WAIT(); }
#pragma unroll 1
        for (int i = 0; i < 4; ++i) attn_pair_unit<1, 0>(p, l, ATT_UN(i), pl, sub, lane, g, i == 0, i < 3 ? ATT_UN(i + 1) : -1);
    }
#undef ATT_UD
#undef ATT_UN
}

#define XB_TMO      128
#define XB_XCNT(j)  (256  + 64 * (j))
#define XB_XSUB(j)  (1280 + 64 * (j))
#define XB_XGEN(j)  (2304 + 64 * (j))
#define XB_TOP      3328
#define XB_TOPGEN   3392
#define XCD_BAR_WORDS 3456
#define XB_SPIN_CAP (1u << 22)
__device__ __forceinline__ unsigned xb_ld(unsigned* p)              { return __hip_atomic_load(p, __ATOMIC_RELAXED, __HIP_MEMORY_SCOPE_AGENT); }
__device__ __forceinline__ unsigned xb_add(unsigned* p, unsigned v) { return __hip_atomic_fetch_add(p, v, __ATOMIC_RELAXED, __HIP_MEMORY_SCOPE_AGENT); }
__device__ __forceinline__ unsigned xb_xcc_id() { return (unsigned)__builtin_amdgcn_s_getreg((3 << 11) | 20) & 0xFu; }
#define XB_SPIN(cond, bar) do { unsigned _sp = 0; while (cond) { __builtin_amdgcn_s_sleep(1); \
    if ((++_sp & 255u) == 0u) { if (xb_ld(&(bar)[XB_TMO])) break; if (_sp > XB_SPIN_CAP) { atomicAdd(&(bar)[XB_TMO], 1u); break; } } } } while (0)
__device__ __forceinline__ void xcd_barrier_post(unsigned* bar) {
    if (threadIdx.x == 0) (void)xb_add(&bar[XB_XCNT(xb_xcc_id())], 1u);
}
__device__ __forceinline__ void xcd_barrier_complete(unsigned* bar, unsigned x, unsigned& nloc, unsigned& nx) {
    const unsigned G = gridDim.x * gridDim.y * gridDim.z;
    unsigned sum, cnt, mine, sp = 0u;
    for (;;) {
        sum = 0u; cnt = 0u; mine = 0u;
#pragma unroll
        for (unsigned j = 0; j < 16; ++j) { const unsigned c = xb_ld(&bar[XB_XCNT(j)]); sum += c; cnt += (c > 0u) ? 1u : 0u; mine = (j == x) ? c : mine; }
        if (sum == G) break;
        __builtin_amdgcn_s_sleep(1);
        if ((++sp & 255u) == 0u) { if (xb_ld(&bar[XB_TMO])) break; if (sp > XB_SPIN_CAP) { atomicAdd(&bar[XB_TMO], 1u); break; } }
    }
    nloc = mine > 0u ? mine : 1u; nx = cnt > 0u ? cnt : 1u;
}
__device__ __forceinline__ void xcd_barrier(unsigned* bar, volatile LAS unsigned* st) {
    asm volatile("s_waitcnt vmcnt(0)" ::: "memory");
    __syncthreads();
    if (threadIdx.x == 0) {
        const unsigned x = xb_xcc_id();
        __builtin_amdgcn_s_waitcnt(0);
        unsigned nloc = st[0], nx = st[1];
        if (nloc == 0u) { xcd_barrier_complete(bar, x, nloc, nx); st[0] = nloc; st[1] = nx; }
        const unsigned old = xb_add(&bar[XB_XSUB(x)], 1u);
        const unsigned gen = old / nloc;
        if (old + 1u == (gen + 1u) * nloc) {
            __builtin_amdgcn_fence(__ATOMIC_RELEASE, "agent");
            asm volatile("s_waitcnt vmcnt(0)" ::: "memory");
            const unsigned og = xb_add(&bar[XB_TOP], 1u);
            const unsigned tg = og / nx;
            if (og + 1u == (tg + 1u) * nx) xb_add(&bar[XB_TOPGEN], 1u);
            else XB_SPIN(xb_ld(&bar[XB_TOPGEN]) == tg, bar);
            __builtin_amdgcn_fence(__ATOMIC_ACQUIRE, "agent");
            xb_add(&bar[XB_XGEN(x)], 1u);
            asm volatile("s_waitcnt vmcnt(0)" ::: "memory");
        } else {
            XB_SPIN(xb_ld(&bar[XB_XGEN(x)]) == gen, bar);
            __builtin_amdgcn_fence(__ATOMIC_ACQUIRE, "agent");
            asm volatile("s_waitcnt vmcnt(0)" ::: "memory");
        }
    }
    __syncthreads();
}

constexpr int NPHASES = 17;

typedef const __attribute__((address_space(4))) Params* ParamsK;
__device__ __forceinline__ void run_phase(int ph, LAS unsigned char* lds) {
    ParamsK pp = (ParamsK)__builtin_amdgcn_kernarg_segment_ptr();
    asm volatile("" : "+s"(pp));
    int tid = threadIdx.x, bid = blockIdx.x;
    asm volatile("" : "+v"(tid)); asm volatile("" : "+s"(bid));
    if (ph == 0) {
        Params p{}; p.ws = pp->ws; p.c = pp->c; p.w_ada = pp->w_ada; p.b_ada = pp->b_ada; p.w_in = pp->w_in; p.w_out = pp->w_out; p.w_mi = pp->w_mi; p.w_mo = pp->w_mo;
        rope_table(p, tid, bid);
        phase_mod(p, lds, tid, bid);
        convert_weights(p, 0, lds, tid, bid);
        return;
    }
    const int l = (ph - 1) >> 3, s = (ph - 1) & 7;
    pg8::StaticOrder S;
    switch (s) {
    case 0: {
        Params p{}; p.ws = pp->ws;
        if (l == 1) { p.w_in = pp->w_in; p.w_out = pp->w_out; p.w_mi = pp->w_mi; p.w_mo = pp->w_mo; convert_weights(p, 1, lds, tid, bid); }
        if (l == 0) phase_norm<false>(pp->x, (bf16_t*)(p.ws + OFF_H), pp->ln1, (const float*)(p.ws + OFF_MOD), 0, 2048, tid, bid);
        else phase_norm<true>(pp->out, (bf16_t*)(p.ws + OFF_H), pp->ln1 + DM, (const float*)(p.ws + OFF_MOD) + (size_t)4 * 12288, 0, 2048, tid, bid);
    } break;
    case 1: {
        unsigned char* ws = pp->ws;
        pg8::Gemm g{(const bf16_t*)(ws + OFF_H), (const bf16_t*)(ws + OFF_WT_IN), MTOK, NQKV, DM};
        S.init(MTOK, NQKV, gridDim.x, bid);
        pg8::EpiQKV E{(bf16_t*)(ws + OFF_BIG), pp->qnd + l * 128, pp->knd + l * 128, pp->qnn + l * 128, pp->knn + l * 128, (const float*)(ws + OFF_ROPE), (LAS float*)(lds + 131072)};
        pg8::gemm_phase(lds, g, S, E, tid);
    } break;
    case 2: { Params p{}; p.ws = pp->ws; p.rpb = pp->rpb; phase_attn(p, l, 0, lds, tid, bid); } break;
    case 3: { Params p{}; p.ws = pp->ws; p.rpb = pp->rpb; phase_attn(p, l, 1, lds, tid, bid); } break;
    case 4: {
        unsigned char* ws = pp->ws;
        pg8::Gemm g{(const bf16_t*)(ws + OFF_H), (const bf16_t*)(ws + OFF_WT_OUT), MTOK, DM, DM};
        S.init(MTOK, DM, gridDim.x, bid, 4);
        const float* gate = (const float*)(ws + OFF_MOD) + (size_t)l * 4 * 12288 + 4096;
        if (l == 0) { pg8::EpiResid<false, true> E{ws + OFF_PART, pp->x, gate}; pg8::gemm_phase(lds, g, S, E, tid); }
        else { pg8::EpiResid<true, true> E{ws + OFF_PART, pp->out, gate}; pg8::gemm_phase(lds, g, S, E, tid); }
    } break;
    case 5: {
        unsigned char* ws = pp->ws;
        phase_norm<true>(ws + OFF_PART, (bf16_t*)(ws + OFF_H), pp->ln2 + l * DM, (const float*)(ws + OFF_MOD) + (size_t)l * 4 * 12288, 6144, 8192, tid, bid);
    } break;
    case 6: {
        unsigned char* ws = pp->ws;
        pg8::Gemm g{(const bf16_t*)(ws + OFF_H), (const bf16_t*)(ws + OFF_WT_MI), MTOK, DFF, DM};
        S.init(MTOK, DFF, gridDim.x, bid);
        pg8::EpiRelu2 E{(bf16_t*)(ws + OFF_BIG), DFF};
        pg8::gemm_phase(lds, g, S, E, tid);
    } break;
    case 7: {
        unsigned char* ws = pp->ws;
        pg8::Gemm g{(const bf16_t*)(ws + OFF_BIG), (const bf16_t*)(ws + OFF_WT_MO), MTOK, DM, DFF};
        S.init(MTOK, DM, gridDim.x, bid, 4);
        const float* gate = (const float*)(ws + OFF_MOD) + (size_t)l * 4 * 12288 + 10240;
        if (l == 0) { pg8::EpiResid<true, true> E{pp->out, ws + OFF_PART, gate}; pg8::gemm_phase(lds, g, S, E, tid); }
        else { pg8::EpiResid<true, false> E{pp->out, ws + OFF_PART, gate}; pg8::gemm_phase(lds, g, S, E, tid); }
    } break;
    }
}

__global__ void __launch_bounds__(512, 2) hybrid_fwd(Params p, int ph_lo, int ph_hi) {
    extern __shared__ __attribute__((aligned(16))) unsigned char shm[];
    LAS unsigned char* lds = (LAS unsigned char*)shm;
    volatile LAS unsigned* st = (volatile LAS unsigned*)(lds + LDS_BYTES - 16);
    unsigned* bar = (unsigned*)(p.ws + OFF_BAR);
    const bool multi = (ph_hi - ph_lo) > 1;
    if (multi) {
        if (threadIdx.x == 0) { st[0] = 0u; st[1] = 0u; }
        xcd_barrier_post(bar);
    }
    if (ph_lo < 0) cg::this_grid().sync();
    for (int ph = ph_lo; ph < ph_hi; ++ph) {
        run_phase(ph, lds);
        if (ph + 1 < ph_hi) { unsigned* b2 = bar; asm volatile("" : "+s"(b2)); xcd_barrier(b2, st); }
    }
}

extern "C" void kernel_launch(void* const* d_in, const int* in_sizes, int n_in, void* d_out, int out_size, void* d_ws, size_t ws_size, hipStream_t stream) {
    static int ready = 0;
    if (!ready) {
        if (n_in != 15 || ws_size < WS_END) { fprintf(stderr, "kernel_launch: unexpected inputs (n_in %d, ws %zu, need %zu)\n", n_in, ws_size, (size_t)WS_END); ready = -1; return; }
        if (hipFuncSetAttribute((const void*)hybrid_fwd, hipFuncAttributeMaxDynamicSharedMemorySize, LDS_BYTES) != hipSuccess) { fprintf(stderr, "kernel_launch: hipFuncSetAttribute failed\n"); ready = -1; return; }
        ready = 1;
    }
    if (ready < 0) return;
    Params p{};
    p.x = (const float*)d_in[0]; p.c = (const float*)d_in[1]; p.ln1 = (const float*)d_in[2]; p.w_ada = (const float*)d_in[3]; p.b_ada = (const float*)d_in[4];
    p.w_in = (const float*)d_in[5]; p.qnd = (const float*)d_in[6]; p.knd = (const float*)d_in[7]; p.qnn = (const float*)d_in[8]; p.knn = (const float*)d_in[9];
    p.rpb = (const float*)d_in[10]; p.w_out = (const float*)d_in[11]; p.ln2 = (const float*)d_in[12]; p.w_mi = (const float*)d_in[13]; p.w_mo = (const float*)d_in[14];
    p.out = (float*)d_out; p.ws = (unsigned char*)d_ws;
    const int grid = 256;
    if (hipMemsetAsync((unsigned char*)d_ws + OFF_BAR, 0, 16384, stream) != hipSuccess) { fprintf(stderr, "kernel_launch: hipMemsetAsync of the barrier words failed\n"); return; }
#if MK_MULTI
    for (int ph = 0; ph < NPHASES; ++ph) {
        hipLaunchKernelGGL(hybrid_fwd, dim3(grid), dim3(512), LDS_BYTES, stream, p, ph, ph + 1);
    }
#else
    int ph_lo = 0, ph_hi = NPHASES;
    void* args[] = {&p, &ph_lo, &ph_hi};
    hipError_t e = hipLaunchCooperativeKernel((const void*)hybrid_fwd, dim3(grid), dim3(512), args, LDS_BYTES, stream);
    if (e != hipSuccess) fprintf(stderr, "cooperative launch failed: %s\n", hipGetErrorString(e));
#endif
}
```
